# Optimizing an MI355X kernel written in HIP

```python
import jax, jax.numpy as jnp
from jax import lax
import numpy as np

D_MODEL = 2048
BATCH = 2
SEQ = 16384
DEPTH = 1
DEC_BATCH = 8
DEC_SEQ = 64
PAST_LEN = 1024

CHUNK = 64
HEAD_DIM = 64
D_MIX = D_MODEL
D_A = D_MIX // 2
D_B = D_MIX - D_A
N_HEADS_A = D_A // HEAD_DIM
N_HEADS_B = D_B // HEAD_DIM
N_KV_B = N_HEADS_B // 4
GROUP_B = N_HEADS_B // N_KV_B
KV_B = N_KV_B * HEAD_DIM
PAST_CHUNKS_A = 8
WINDOW_B = 128
PAST_CHUNKS_B = WINDOW_B // CHUNK
PAST_ROWS_A = PAST_CHUNKS_A * CHUNK
PAST_ROWS_B = PAST_CHUNKS_B * CHUNK
REL_CLIP = 256
N_REL = REL_CLIP + CHUNK
SPLIT_SIZES = (D_A, D_A, D_A, D_A, D_B, KV_B, KV_B, D_B)
D_IN = sum(SPLIT_SIZES)
RMS_EPS = 1e-6
NEG_INF = -1e30

kernel_name = 'chunk_relpos_swa_sink_hybrid_step'


def rms_norm(x, g):
    xf = x.astype(jnp.float32)
    y = xf * lax.rsqrt(jnp.mean(xf * xf, axis=-1, keepdims=True) + RMS_EPS)
    return (y * g.astype(jnp.float32)).astype(x.dtype)


def band_distances(past_rows):
    return past_rows + np.arange(CHUNK)[:, None] - np.arange(past_rows + CHUNK)[None, :]


def rel_position_bias(table):
    idx = np.clip(band_distances(PAST_ROWS_A), -(CHUNK - 1), REL_CLIP) + (CHUNK - 1)
    return table.astype(jnp.float32)[:, idx][:, None]


def alibi_bias():
    d = np.abs(band_distances(PAST_ROWS_B)).astype(np.float32)
    slopes = (2.0 ** (-8.0 * np.arange(1, N_HEADS_B + 1, dtype=np.float32) / N_HEADS_B)).astype(np.float32)
    bias = -slopes[:, None, None] * d[None]
    return jnp.asarray(bias.reshape(N_KV_B, GROUP_B, CHUNK, -1), dtype=jnp.float32)


def key_validity(past_rows, n_hist, n_new, n_rows):
    idx = np.arange(n_rows)
    return jnp.asarray(((idx >= past_rows - n_hist) & (idx < past_rows + n_new))[None, :])


def chunk_band_attention(q, k_full, v_full, key_valid, bias, sinks):
    band = bias.shape[-1]
    n_chunks = q.shape[1] // CHUNK
    scale = HEAD_DIM ** -0.5

    def one_chunk(c):
        start = c * CHUNK
        qc = lax.dynamic_slice_in_dim(q, start, CHUNK, axis=1)
        kc = lax.dynamic_slice_in_dim(k_full, start, band, axis=1)
        vc = lax.dynamic_slice_in_dim(v_full, start, band, axis=1)
        ok = lax.dynamic_slice_in_dim(key_valid, start, band, axis=1)
        s = jnp.einsum('bqhgd,bkhd->bhgqk', qc, kc).astype(jnp.float32) * scale + bias
        s = jnp.where(ok[:, None, None, None, :], s, NEG_INF)
        if sinks is None:
            p = jax.nn.softmax(s, axis=-1)
        else:
            sink = sinks.astype(jnp.float32)[None, :, :, None, None]
            m = jnp.maximum(jnp.max(s, axis=-1, keepdims=True), sink)
            e = jnp.exp(s - m)
            p = e / (jnp.sum(e, axis=-1, keepdims=True) + jnp.exp(sink - m))
        return jnp.einsum('bhgqk,bkhd->bqhgd', p.astype(vc.dtype), vc)

    out = lax.map(one_chunk, jnp.arange(n_chunks))
    return jnp.moveaxis(out, 0, 1).reshape(q.shape)


def mixer_layer(x, hist_ak, hist_av, hist_bk, hist_bv, valid_a, valid_b,
                norm_g, w_in, rel_table, sinks, w_out):
    b, s, _ = x.shape
    h = rms_norm(x, norm_g)
    z = jnp.einsum('bsd,de->bse', h, w_in)
    offsets = list(np.cumsum(SPLIT_SIZES)[:-1])
    qa, ka, va, ga, qb, kb, vb, gb = jnp.split(z, offsets, axis=-1)
    qa = qa.reshape(b, s, N_HEADS_A, 1, HEAD_DIM)
    ka = ka.reshape(b, s, N_HEADS_A, HEAD_DIM)
    va = va.reshape(b, s, N_HEADS_A, HEAD_DIM)
    qb = qb.reshape(b, s, N_KV_B, GROUP_B, HEAD_DIM)
    kb = kb.reshape(b, s, N_KV_B, HEAD_DIM)
    vb = vb.reshape(b, s, N_KV_B, HEAD_DIM)
    oa = chunk_band_attention(qa, jnp.concatenate([hist_ak, ka], axis=1),
                              jnp.concatenate([hist_av, va], axis=1),
                              valid_a, rel_position_bias(rel_table), None)
    ob = chunk_band_attention(qb, jnp.concatenate([hist_bk, kb], axis=1),
                              jnp.concatenate([hist_bv, vb], axis=1),
                              valid_b, alibi_bias(), sinks.reshape(N_KV_B, GROUP_B))
    o = jnp.concatenate([oa.reshape(b, s, D_A) * jax.nn.silu(ga),
                         ob.reshape(b, s, D_B) * jax.nn.silu(gb)], axis=-1)
    y = x + jnp.einsum('bse,ed->bsd', o, w_out)
    return y, ka, va, kb, vb


def setup_inputs(seed: int = 0) -> dict:
    key = jax.random.key(seed)
    ks = jax.random.split(key, 12)
    la = min(PAST_ROWS_A, PAST_LEN)
    lb = min(PAST_ROWS_B, PAST_LEN)
    f32 = jnp.float32
    return {
        'x_prompt': jax.random.normal(ks[0], (BATCH, SEQ, D_MODEL), f32),
        'x_sample': jax.random.normal(ks[1], (DEC_BATCH, DEC_SEQ, D_MODEL), f32),
        'cache_a_k': jax.random.normal(ks[2], (DEPTH, DEC_BATCH, la, N_HEADS_A, HEAD_DIM), f32),
        'cache_a_v': jax.random.normal(ks[3], (DEPTH, DEC_BATCH, la, N_HEADS_A, HEAD_DIM), f32),
        'cache_b_k': jax.random.normal(ks[4], (DEPTH, DEC_BATCH, lb, N_KV_B, HEAD_DIM), f32),
        'cache_b_v': jax.random.normal(ks[5], (DEPTH, DEC_BATCH, lb, N_KV_B, HEAD_DIM), f32),
        'norm_in': 1.0 + 0.05 * jax.random.normal(ks[6], (DEPTH, D_MODEL), f32),
        'w_in': jax.random.normal(ks[7], (DEPTH, D_MODEL, D_IN), f32) * D_MODEL ** -0.5,
        'rel_bias_a': 0.2 * jax.random.normal(ks[8], (DEPTH, N_HEADS_A, N_REL), f32),
        'sinks_b': jax.random.normal(ks[9], (DEPTH, N_HEADS_B), f32),
        'w_out': jax.random.normal(ks[10], (DEPTH, D_MIX, D_MODEL), f32) * D_MIX ** -0.5,
        'norm_final': 1.0 + 0.05 * jax.random.normal(ks[11], (D_MODEL,), f32),
    }


def reference(x_prompt, x_sample, cache_a_k, cache_a_v, cache_b_k, cache_b_v,
              norm_in, w_in, rel_bias_a, sinks_b, w_out, norm_final):
    b_p, seq, _ = x_prompt.shape
    b_s, n_new, _ = x_sample.shape
    la = cache_a_k.shape[2]
    lb = cache_b_k.shape[2]
    s_pad = -(-n_new // CHUNK) * CHUNK
    keep_a = min(PAST_ROWS_A, seq)
    keep_b = min(PAST_ROWS_B, seq)

    valid_a_p = key_validity(PAST_ROWS_A, 0, seq, PAST_ROWS_A + seq)
    valid_b_p = key_validity(PAST_ROWS_B, 0, seq, PAST_ROWS_B + seq)
    valid_a_s = key_validity(PAST_ROWS_A, la, n_new, PAST_ROWS_A + s_pad)
    valid_b_s = key_validity(PAST_ROWS_B, lb, n_new, PAST_ROWS_B + s_pad)

    hp = x_prompt
    hs = jnp.pad(x_sample, ((0, 0), (0, s_pad - n_new), (0, 0)))
    ak_p, av_p, bk_p, bv_p = [], [], [], []
    ak_s, av_s, bk_s, bv_s = [], [], [], []
    for l in range(DEPTH):
        za = jnp.zeros((b_p, PAST_ROWS_A, N_HEADS_A, HEAD_DIM), hp.dtype)
        zb = jnp.zeros((b_p, PAST_ROWS_B, N_KV_B, HEAD_DIM), hp.dtype)
        hp, ka, va, kb, vb = mixer_layer(hp, za, za, zb, zb, valid_a_p, valid_b_p,
                                         norm_in[l], w_in[l], rel_bias_a[l], sinks_b[l], w_out[l])
        ak_p.append(ka[:, seq - keep_a:])
        av_p.append(va[:, seq - keep_a:])
        bk_p.append(kb[:, seq - keep_b:])
        bv_p.append(vb[:, seq - keep_b:])
        pad_a = ((0, 0), (PAST_ROWS_A - la, 0), (0, 0), (0, 0))
        pad_b = ((0, 0), (PAST_ROWS_B - lb, 0), (0, 0), (0, 0))
        hs, ka, va, kb, vb = mixer_layer(hs, jnp.pad(cache_a_k[l], pad_a), jnp.pad(cache_a_v[l], pad_a),
                                         jnp.pad(cache_b_k[l], pad_b), jnp.pad(cache_b_v[l], pad_b),
                                         valid_a_s, valid_b_s,
                                         norm_in[l], w_in[l], rel_bias_a[l], sinks_b[l], w_out[l])
        ak_s.append(jnp.concatenate([cache_a_k[l], ka[:, :n_new]], axis=1)[:, n_new:])
        av_s.append(jnp.concatenate([cache_a_v[l], va[:, :n_new]], axis=1)[:, n_new:])
        bk_s.append(jnp.concatenate([cache_b_k[l], kb[:, :n_new]], axis=1)[:, n_new:])
        bv_s.append(jnp.concatenate([cache_b_v[l], vb[:, :n_new]], axis=1)[:, n_new:])

    y_prompt = rms_norm(hp, norm_final)
    y_sample = rms_norm(hs[:, :n_new], norm_final)
    return (y_prompt, y_sample,
            jnp.stack(ak_p), jnp.stack(av_p), jnp.stack(bk_p), jnp.stack(bv_p),
            jnp.stack(ak_s), jnp.stack(av_s), jnp.stack(bk_s), jnp.stack(bv_s))
```

```cpp
#include <hip/hip_runtime.h>
#include <hip/hip_cooperative_groups.h>
#include <cstdio>
#include <cstdint>
namespace cg = cooperative_groups;

#define LAS __attribute__((address_space(3)))
typedef unsigned short bf16_t;
typedef short bf16x8 __attribute__((ext_vector_type(8)));
typedef float f32x4 __attribute__((ext_vector_type(4)));
typedef float f32x16 __attribute__((ext_vector_type(16)));
typedef unsigned u32x4 __attribute__((ext_vector_type(4)));
typedef unsigned u32x2 __attribute__((ext_vector_type(2)));

constexpr int DM = 2048, NTOKP = 32768, NTOK = 33280;
constexpr int LDZ = 5376;
constexpr size_t ZHS = (size_t)33280 * 64;
constexpr int NVC = 1280, LDV = NTOK;
constexpr float LOG2E = 1.4426950408889634f;
constexpr float C2 = 0.125f * LOG2E;
constexpr float RMS_EPS = 1e-6f;
constexpr size_t OFF_AKP = 68157440, OFF_AVP = 69206016, OFF_BKP = 70254592, OFF_BVP = 70320128,
                 OFF_AKS = 70385664, OFF_AVS = 74579968, OFF_BKS = 78774272, OFF_BVS = 79036416;
constexpr size_t MiB = 1u << 20;
constexpr size_t WS_XB = 0, WS_O = 0, WS_W1T = 130 * MiB, WS_W2T = 156 * MiB, WS_Z = 164 * MiB, WS_VT = WS_Z + 357826560,
                 WS_CAK = WS_VT + 85196800, WS_CAVT = WS_CAK + 8 * MiB, WS_CBK = WS_CAVT + 8 * MiB, WS_CBVT = WS_CBK + MiB / 2,
                 WS_RS = WS_CBVT + MiB / 2, WS_PSS = WS_RS + MiB, WS_XS = WS_PSS + 5 * MiB, WS_TAB = WS_XS + 4 * MiB, WS_SINK = WS_TAB + 32768, WS_GF = WS_SINK + 4096, WS_PS = WS_GF + 8192, WS_BAR = WS_PS + 32 * MiB, WS_END = WS_BAR + 16384;
constexpr int MISC_OFF = 153600, LDS_BYTES = 153600 + 64;

struct Params { const float* in[12]; float* out; unsigned char* ws; int ph_lo, ph_hi; };

__device__ __forceinline__ unsigned cvt_pk(float lo, float hi) {
    typedef float f2 __attribute__((ext_vector_type(2))); typedef __bf16 b2 __attribute__((ext_vector_type(2)));
    f2 v = {lo, hi}; b2 b = __builtin_convertvector(v, b2); return __builtin_bit_cast(unsigned, b);
}
__device__ __forceinline__ float bf2f(unsigned short b) { return __uint_as_float((unsigned)b << 16); }
__device__ __forceinline__ float wave_sum(float v) {
#pragma unroll
    for (int o = 1; o < 64; o <<= 1) v += __shfl_xor(v, o);
    return v;
}
#define LDS_WAIT() asm volatile("s_waitcnt lgkmcnt(0)" ::: "memory")
typedef const __attribute__((address_space(4))) Params* kparams_t;
__device__ __forceinline__ kparams_t fresh_params() { kparams_t kp = (kparams_t)__builtin_amdgcn_kernarg_segment_ptr(); asm volatile("" : "+s"(kp)); return kp; }

#define XB_TMO      128
#define XB_XCNT(j)  (256  + 64 * (j))
#define XB_XSUB(j)  (1280 + 64 * (j))
#define XB_XGEN(j)  (2304 + 64 * (j))
#define XB_TOP      3328
#define XB_TOPGEN   3392
#define XCD_BAR_WORDS 3456
#define XB_SPIN_CAP (1u << 18)

__device__ __forceinline__ unsigned xb_ld(unsigned* p)              { return __hip_atomic_load(p, __ATOMIC_RELAXED, __HIP_MEMORY_SCOPE_AGENT); }
__device__ __forceinline__ unsigned xb_add(unsigned* p, unsigned v) { return __hip_atomic_fetch_add(p, v, __ATOMIC_RELAXED, __HIP_MEMORY_SCOPE_AGENT); }
__device__ __forceinline__ unsigned xb_xcc_id() { return (unsigned)__builtin_amdgcn_s_getreg((3 << 11) | 20) & 0xFu; }
#define XB_SPIN(cond, bar) do { unsigned _sp = 0; while (cond) { __builtin_amdgcn_s_sleep(1); \
    if ((++_sp & 255u) == 0u) { if (xb_ld(&(bar)[XB_TMO])) break; if (_sp > XB_SPIN_CAP) { atomicAdd(&(bar)[XB_TMO], 1u); break; } } } } while (0)

struct XcdBarrier {
    unsigned* bar; unsigned x;
    volatile LAS unsigned* st;
};

__device__ __forceinline__ XcdBarrier xcd_barrier_post(unsigned* bar, volatile LAS unsigned* st) {
    XcdBarrier b; b.bar = bar; b.x = xb_xcc_id(); b.st = st;
    if (threadIdx.x == 0) (void)xb_add(&bar[XB_XCNT(b.x)], 1u);
    return b;
}
__device__ __forceinline__ void xcd_barrier_complete(unsigned* bar, unsigned x, unsigned& nloc, unsigned& nx) {
    const unsigned G = gridDim.x * gridDim.y * gridDim.z;
    unsigned sum, cnt, mine, sp = 0u;
    for (;;) {
        sum = 0u; cnt = 0u; mine = 0u;
#pragma unroll
        for (unsigned j = 0; j < 16; ++j) { const unsigned c = xb_ld(&bar[XB_XCNT(j)]); sum += c; cnt += (c > 0u) ? 1u : 0u; mine = (j == x) ? c : mine; }
        if (sum == G) break;
        __builtin_amdgcn_s_sleep(1);
        if ((++sp & 255u) == 0u) { if (xb_ld(&bar[XB_TMO])) break; if (sp > XB_SPIN_CAP) { atomicAdd(&bar[XB_TMO], 1u); break; } }
    }
    nloc = mine > 0u ? mine : 1u; nx = cnt > 0u ? cnt : 1u;
}

__device__ __forceinline__ void xcd_barrier(const XcdBarrier& b) {
    asm volatile("s_waitcnt vmcnt(0)" ::: "memory");
    __syncthreads();
    if (threadIdx.x == 0) {
        unsigned* bar = b.bar;
        __builtin_amdgcn_s_waitcnt(0);
        unsigned nloc = b.st[0], nx = b.st[1];
        if (nloc == 0u) { xcd_barrier_complete(bar, b.x, nloc, nx); b.st[0] = nloc; b.st[1] = nx; }
        const unsigned old = xb_add(&bar[XB_XSUB(b.x)], 1u);
        const unsigned gen = old / nloc;
        if (old + 1u == (gen + 1u) * nloc) {
            __builtin_amdgcn_fence(__ATOMIC_RELEASE, "agent");
            asm volatile("s_waitcnt vmcnt(0)" ::: "memory");
            const unsigned og = xb_add(&bar[XB_TOP], 1u);
            const unsigned tg = og / nx;
            if (og + 1u == (tg + 1u) * nx) xb_add(&bar[XB_TOPGEN], 1u);
            else XB_SPIN(xb_ld(&bar[XB_TOPGEN]) == tg, bar);
            __builtin_amdgcn_fence(__ATOMIC_ACQUIRE, "agent");
            xb_add(&bar[XB_XGEN(b.x)], 1u);
            asm volatile("s_waitcnt vmcnt(0)" ::: "memory");
        } else {
            XB_SPIN(xb_ld(&bar[XB_XGEN(b.x)]) == gen, bar);
            __builtin_amdgcn_fence(__ATOMIC_ACQUIRE, "agent");
            asm volatile("s_waitcnt vmcnt(0)" ::: "memory");
        }
    }
    __syncthreads();
}


namespace pg8 {
#define PG8_LAS __attribute__((address_space(3)))
typedef unsigned short bf16_t;
typedef short bf16x8 __attribute__((ext_vector_type(8)));
typedef float f32x4 __attribute__((ext_vector_type(4)));
typedef unsigned u32x4 __attribute__((ext_vector_type(4)));
constexpr int BM = 256, BK = 64, HALF = 128, HTB = HALF * BK * 2  , STAGE_BYTES = 8 * HTB, NXCD = 8, WGM = 8;

__host__ __device__ __forceinline__ int lds_byte(int r, int c) { const int st = (r >> 4) * 2 + (c >> 5), rr = r & 15, cc = c & 31, ob = rr * 64 + cc * 2; return st * 1024 + (ob ^ (((ob >> 9) & 1) << 5)); }
__host__ __device__ __forceinline__ void stage_rc(int b, int& R, int& C) { const int st = b / 1024, sb = b % 1024, swz = sb ^ (((sb >> 9) & 1) << 5); R = (st >> 1) * 16 + swz / 64; C = (st & 1) * 32 + (swz % 64) / 2; }
__host__ __device__ __forceinline__ int perm32(int rho) { const int n = rho >> 4, i = rho & 15; return 8 * (i >> 2) + 4 * n + (i & 3); }

struct Unit { int pm, pn, ko; };
struct Gemm { const bf16_t* A; const bf16_t* Bt; int M, N, K, ld; };

struct StaticOrder {
    int nM, nN, nwg, G, c;
    __host__ __device__ __forceinline__ void init(int M, int N, int G_, int c_) { nM = M / BM; nN = N / BM; nwg = nM * nN; G = G_; c = c_; }
    __host__ __device__ __forceinline__ bool next(int i, Unit& u) const {
        const long L = (long)i * G + c; if (L >= nwg) return false;
        int wgid = (int)L; { const int q = nwg / NXCD, r = nwg % NXCD, xcd = wgid % NXCD, off = wgid / NXCD; wgid = (xcd < r ? xcd * (q + 1) : r * (q + 1) + (xcd - r) * q) + off; }
        const int nig = WGM * nN, gid = wgid / nig, fm = gid * WGM, gsz = (nM - fm) < WGM ? (nM - fm) : WGM;
        u.pm = fm + ((wgid % nig) % gsz); u.pn = (wgid % nig) / gsz; u.ko = 0; return true;
    }
    __device__ __forceinline__ void a_ready(const Unit&) const {}
    __device__ __forceinline__ void done(const Unit&) const {}
};

}
namespace pg8 {
struct EpiZ {
    static constexpr bool PERM = true, AFTER_DRAIN = false;
    bf16_t* Z; const float* rs; float* out;
    __device__ __forceinline__ void operator()(const f32x4 (&acc)[2][2][4][2], const Unit& u, int wr, int wc, int fr, int fq) const {
        const int row0 = u.pm * BM + wr * 64 + fr;
        const int col0 = u.pn * BM + wc * 32 + 8 * fq;
        const bool isKa = (u.pn >= 4 && u.pn < 8), isKb = (u.pn == 16);
        const bool ctile = (isKa || isKb) && (u.pm >= 128 || (u.pm & 63) >= 62);
#pragma unroll
        for (int ai = 0; ai < 2; ++ai)
#pragma unroll
            for (int m = 0; m < 4; ++m) {
                const int r = row0 + ai * HALF + m * 16;
#pragma unroll
                for (int bj = 0; bj < 2; ++bj) {
                    const f32x4 v0 = acc[ai][bj][m][0], v1 = acc[ai][bj][m][1];
                    u32x4 w; w.x = cvt_pk(v0[0], v0[1]); w.y = cvt_pk(v0[2], v0[3]); w.z = cvt_pk(v1[0], v1[1]); w.w = cvt_pk(v1[2], v1[3]);
                    { const int cc = col0 + bj * HALF; *(u32x4*)(Z + ((size_t)(cc >> 6) * NTOK + r) * 64 + (cc & 63)) = w; }
                    if (ctile) {
                        float* dst = nullptr; const int c = col0 + bj * HALF;
                        if (r >= NTOKP) { const int sidx = r - NTOKP, b = sidx >> 6, i = sidx & 63;
                            dst = isKa ? out + OFF_AKS + ((size_t)(b * 512 + 448 + i) * 1024 + (c - 1024)) : out + OFF_BKS + ((size_t)(b * 128 + 64 + i) * 256 + (c - 4096)); }
                        else { const int b = r >> 14, t = r & 16383;
                            if (isKa) { if (t >= 15872) dst = out + OFF_AKP + ((size_t)(b * 512 + t - 15872) * 1024 + (c - 1024)); }
                            else      { if (t >= 16256) dst = out + OFF_BKP + ((size_t)(b * 128 + t - 16256) * 256 + (c - 4096)); } }
                        if (dst) { *(f32x4*)dst = v0; *(f32x4*)(dst + 4) = v1; }
                    }
                }
            }
    }
};
struct EpiVt {
    static constexpr bool PERM = true, AFTER_DRAIN = false;
    bf16_t* VT; const float* rs; float* out;
    __device__ __forceinline__ void operator()(const f32x4 (&acc)[2][2][4][2], const Unit& u, int wr, int wc, int fr, int fq) const {
        const int row0 = u.pm * BM + wr * 64 + fr;
        const int tok0 = u.pn * BM + wc * 32 + 8 * fq;
        const bool ctile = (u.pn >= 128 || (u.pn & 63) >= 62);
#pragma unroll
        for (int ai = 0; ai < 2; ++ai)
#pragma unroll
            for (int m = 0; m < 4; ++m) {
                const int r = row0 + ai * HALF + m * 16;
#pragma unroll
                for (int bj = 0; bj < 2; ++bj) {
                    const f32x4 v0 = acc[ai][bj][m][0], v1 = acc[ai][bj][m][1];
                    u32x4 w; w.x = cvt_pk(v0[0], v0[1]); w.y = cvt_pk(v0[2], v0[3]); w.z = cvt_pk(v1[0], v1[1]); w.w = cvt_pk(v1[2], v1[3]);
                    { const int tk0 = tok0 + bj * HALF; *(u32x4*)(VT + ((size_t)(tk0 >> 6) * NVC + r) * 64 + (tk0 & 63)) = w; }
                    if (ctile) {
#pragma unroll
                        for (int e = 0; e < 8; ++e) {
                            const int tk = tok0 + bj * HALF + e; const float val = e < 4 ? v0[e & 3] : v1[e & 3];
                            if (tk >= NTOKP) { const int sidx = tk - NTOKP, b = sidx >> 6, i = sidx & 63;
                                if (r < 1024) out[OFF_AVS + (size_t)(b * 512 + 448 + i) * 1024 + r] = val;
                                else          out[OFF_BVS + (size_t)(b * 128 + 64 + i) * 256 + (r - 1024)] = val; }
                            else { const int b = tk >> 14, t = tk & 16383;
                                if (r < 1024) { if (t >= 15872) out[OFF_AVP + (size_t)(b * 512 + t - 15872) * 1024 + r] = val; }
                                else          { if (t >= 16256) out[OFF_BVP + (size_t)(b * 128 + t - 16256) * 256 + (r - 1024)] = val; } }
                        }
                    }
                }
            }
    }
};
struct SplitK8 {
    int G, c;
    __device__ __forceinline__ bool next(int i, Unit& u) const { const int L = i * G + c; if (L >= 128) return false; const int t = L >> 3; u.pm = 128 + (t >> 3); u.pn = t & 7; u.ko = 256 * (L & 7); return true; }
    __device__ __forceinline__ void a_ready(const Unit&) const {}
    __device__ __forceinline__ void done(const Unit&) const {}
};
struct EpiYS {
    static constexpr bool PERM = false, AFTER_DRAIN = false;
    float* YS;
    __device__ __forceinline__ void operator()(const f32x4 (&acc)[2][2][4][2], const Unit& u, int wr, int wc, int fr, int fq) const {
        const int col0 = u.pn * BM + wc * 32 + 4 * fq;
#pragma unroll
        for (int ai = 0; ai < 2; ++ai)
#pragma unroll
            for (int m = 0; m < 4; ++m) {
                float* yrow = YS + ((size_t)(u.ko >> 8) * 512 + (u.pm - 128) * BM + ai * HALF + wr * 64 + m * 16 + fr) * DM + col0;
#pragma unroll
                for (int bj = 0; bj < 2; ++bj)
#pragma unroll
                    for (int n = 0; n < 2; ++n) *(f32x4*)(yrow + bj * HALF + n * 16) = acc[ai][bj][m][n];
            }
    }
};
struct EpiY {
    static constexpr bool PERM = true, AFTER_DRAIN = false;
    const float* xp; const float* xs; bf16_t* YB; float* pss;
    __device__ __forceinline__ const float* xrow(int r) const { return (r < NTOKP) ? xp + (size_t)r * DM : xs + (size_t)(r - NTOKP) * DM; }
    __device__ __forceinline__ void operator()(const f32x4 (&acc)[2][2][4][2], const Unit& u, int wr, int wc, int fr, int fq) const {
        const int col0 = u.pn * BM + wc * 32 + 8 * fq;
        const int rbase = u.pm * BM + wr * 64 + fr;
        f32x4 xv[2][2];
        { const float* xr = xrow(rbase) + col0; xv[0][0] = *(const f32x4*)(xr); xv[0][1] = *(const f32x4*)(xr + 4); }
        float q = 0.f;
#pragma unroll
        for (int s2 = 0; s2 < 16; ++s2) {
            const int g = s2 >> 1, bj = s2 & 1, ai = g >> 2, m = g & 3, cb = s2 & 1;
            if (s2 + 1 < 16) { const int g1 = (s2 + 1) >> 1, bj1 = (s2 + 1) & 1; const int r1 = rbase + (g1 >> 2) * HALF + (g1 & 3) * 16; const float* xr = xrow(r1) + col0 + bj1 * HALF;
                xv[cb ^ 1][0] = *(const f32x4*)(xr); xv[cb ^ 1][1] = *(const f32x4*)(xr + 4); }
            const int r = rbase + ai * HALF + m * 16;
            const f32x4 y0 = xv[cb][0] + acc[ai][bj][m][0], y1 = xv[cb][1] + acc[ai][bj][m][1];
            u32x4 w; w.x = cvt_pk(y0[0], y0[1]); w.y = cvt_pk(y0[2], y0[3]); w.z = cvt_pk(y1[0], y1[1]); w.w = cvt_pk(y1[2], y1[3]);
            *(u32x4*)(YB + (size_t)r * DM + col0 + bj * HALF) = w;
            q += (y0[0] * y0[0] + y0[1] * y0[1]) + (y0[2] * y0[2] + y0[3] * y0[3]) + (y1[0] * y1[0] + y1[1] * y1[1]) + (y1[2] * y1[2] + y1[3] * y1[3]);
            if (bj == 1) { q += __shfl_xor(q, 16); q += __shfl_xor(q, 32); if (fq == 0) pss[(size_t)r * 32 + u.pn * 4 + wc] = q; q = 0.f; }
        }
    }
};
}

namespace pg8 {
template <class Epi, class Sched, bool ALIGN_EPI = false, bool SP2 = false>
__device__ __forceinline__ void gemm_phase(PG8_LAS unsigned char* lds, const Gemm g, const Sched& S, const Epi& E) {
    int tid_ = threadIdx.x; asm volatile("" : "+v"(tid_)); const int tid = tid_, wid = __builtin_amdgcn_readfirstlane(tid >> 6), lane = tid & 63, wr = wid >> 2, wc = wid & 3, fr = lane & 15, fq = lane >> 4;
    const int K = g.K, nt = K / BK, LD = g.ld;
    unsigned voffA[2], voffB[2];
#pragma unroll
    for (int i = 0; i < 2; ++i) { int R, C; stage_rc(tid * 16 + i * 8192, R, C); const int Rb = Epi::PERM ? ((R & ~31) + perm32(R & 31)) : R;
        voffA[i] = (unsigned)(R * LD + C) * 2u; voffB[i] = (unsigned)(Rb * LD + C) * 2u; }
    const size_t kstep = (size_t)(BK * 2);
    const size_t hstep = (size_t)HALF * LD * 2;
    const size_t tstep = 2 * hstep;
    const unsigned ldsw = (unsigned)wid * 1024u;
    const int aoff = lds_byte(wr * 64 + fr, fq * 8), boff = lds_byte(wc * 32 + fr, fq * 8);
#define PG8_SA(b, h) (((b) * 2 + (h)) * HTB)
#define PG8_SB(b, h) ((4 + (b) * 2 + (h)) * HTB)
#define PG8_STAGE(bufoff, gbase, voff) do { _Pragma("unroll") for (int _i = 0; _i < 2; ++_i) \
        __builtin_amdgcn_global_load_lds((const unsigned*)((const char*)(gbase) + (voff)[_i]), (PG8_LAS unsigned*)(lds + (bufoff) + ldsw + _i * 8192), 16, 0, 0); } while (0)
#define PG8_LDA(dst, b, h) do { _Pragma("unroll") for (int m = 0; m < 4; ++m) _Pragma("unroll") for (int k = 0; k < 2; ++k) dst[m][k] = *(const PG8_LAS bf16x8*)(lds + PG8_SA(b, h) + aoff + m * 2048 + k * 1024); } while (0)
#define PG8_LDB(dst, b, h) do { _Pragma("unroll") for (int n = 0; n < 2; ++n) _Pragma("unroll") for (int k = 0; k < 2; ++k) dst[n][k] = *(const PG8_LAS bf16x8*)(lds + PG8_SB(b, h) + boff + n * 2048 + k * 1024); } while (0)
#define PG8_MMA(ai, bj, At, Bt) do { __builtin_amdgcn_s_setprio(1); _Pragma("unroll") for (int m = 0; m < 4; ++m) _Pragma("unroll") for (int n = 0; n < 2; ++n) _Pragma("unroll") for (int k = 0; k < 2; ++k) \
        acc[ai][bj][m][n] = __builtin_amdgcn_mfma_f32_16x16x32_bf16(Bt[n][k], At[m][k], acc[ai][bj][m][n], 0, 0, 0); __builtin_amdgcn_s_setprio(0); } while (0)
#define PG8_WAIT_V(n) asm volatile("s_waitcnt vmcnt(" #n ")" ::: "memory")
#define PG8_WAIT_L(n) asm volatile("s_waitcnt lgkmcnt(" #n ")" ::: "memory")
#define PG8_BAR __builtin_amdgcn_s_barrier()
#define PG8_SCHED __builtin_amdgcn_sched_barrier(0)
    Unit cur, nxt; int ui = 0;
    if (!S.next(0, cur)) return;
    f32x4 acc[2][2][4][2];
#pragma unroll
    for (int a = 0; a < 2; ++a)
#pragma unroll
        for (int b = 0; b < 2; ++b)
#pragma unroll
            for (int m = 0; m < 4; ++m)
#pragma unroll
                for (int n = 0; n < 2; ++n) acc[a][b][m][n] = (f32x4){0.f, 0.f, 0.f, 0.f};
    bf16x8 At[4][2], B0[2][2], B1[2][2];
    const char* cA = (const char*)g.A + (size_t)cur.pm * tstep + (size_t)cur.ko * 2; const char* cB = (const char*)g.Bt + (size_t)cur.pn * tstep + (size_t)cur.ko * 2;
    S.a_ready(cur);
    if constexpr (SP2) {
        PG8_STAGE(PG8_SB(0, 0), cB, voffB); PG8_STAGE(PG8_SB(0, 1), cB + hstep, voffB); PG8_STAGE(PG8_SA(0, 0), cA, voffA); PG8_STAGE(PG8_SA(0, 1), cA + hstep, voffA);
        if (wr == 1) PG8_BAR;
        PG8_WAIT_V(2); PG8_BAR;
        PG8_STAGE(PG8_SB(1, 0), cB + kstep, voffB); PG8_STAGE(PG8_SA(1, 0), cA + kstep, voffA); PG8_STAGE(PG8_SB(1, 1), cB + hstep + kstep, voffB);
        PG8_WAIT_V(6); PG8_BAR;
    } else {
        PG8_STAGE(PG8_SB(0, 0), cB, voffB); PG8_STAGE(PG8_SA(0, 0), cA, voffA); PG8_STAGE(PG8_SB(0, 1), cB + hstep, voffB); PG8_STAGE(PG8_SA(0, 1), cA + hstep, voffA);
        if (wr == 1) PG8_BAR;
        PG8_WAIT_V(4); PG8_BAR;
        PG8_STAGE(PG8_SB(1, 0), cB + kstep, voffB); PG8_STAGE(PG8_SA(1, 0), cA + kstep, voffA); PG8_STAGE(PG8_SB(1, 1), cB + hstep + kstep, voffB);
        PG8_WAIT_V(6); PG8_BAR;
    }
    for (;;) {
        const bool has_next = S.next(ui + 1, nxt);
        const char* nA = has_next ? (const char*)g.A + (size_t)nxt.pm * tstep + (size_t)nxt.ko * 2 : cA; const char* nB = has_next ? (const char*)g.Bt + (size_t)nxt.pn * tstep + (size_t)nxt.ko * 2 : cB;
        for (int t = 0; t < nt; t += 2) {
            const bool last = (t == nt - 2);
            const char* a1 = cA + (size_t)(t + 1) * kstep;
            const char* a2 = last ? nA : cA + (size_t)(t + 2) * kstep; const char* b2 = last ? nB : cB + (size_t)(t + 2) * kstep;
            const char* a3 = a2 + kstep; const char* b3 = b2 + kstep;
            if (last && has_next) S.a_ready(nxt);
            if constexpr (SP2) {
            PG8_LDB(B0, 0, 0); PG8_LDB(B1, 0, 1); PG8_SCHED; PG8_LDA(At, 0, 0); PG8_STAGE(PG8_SA(1, 1), a1 + hstep, voffA);
            PG8_WAIT_V(8); PG8_WAIT_L(0); PG8_BAR; PG8_MMA(0, 0, At, B0); PG8_MMA(0, 1, At, B1); PG8_BAR; PG8_SCHED;
            PG8_LDA(At, 0, 1); PG8_STAGE(PG8_SB(0, 0), b2, voffB); PG8_STAGE(PG8_SB(0, 1), b2 + hstep, voffB); PG8_STAGE(PG8_SA(0, 0), a2, voffA);
            PG8_WAIT_V(8); PG8_WAIT_L(0); PG8_BAR; PG8_MMA(1, 0, At, B0); PG8_MMA(1, 1, At, B1); PG8_BAR; PG8_SCHED;
            PG8_LDB(B0, 1, 0); PG8_LDB(B1, 1, 1); PG8_SCHED; PG8_LDA(At, 1, 0); PG8_STAGE(PG8_SA(0, 1), a2 + hstep, voffA);
            PG8_WAIT_V(8); PG8_WAIT_L(0); PG8_BAR; PG8_MMA(0, 0, At, B0); PG8_MMA(0, 1, At, B1); PG8_BAR; PG8_SCHED;
            PG8_LDA(At, 1, 1); PG8_STAGE(PG8_SB(1, 0), b3, voffB); PG8_STAGE(PG8_SB(1, 1), b3 + hstep, voffB); PG8_STAGE(PG8_SA(1, 0), a3, voffA);
            PG8_WAIT_V(8); PG8_WAIT_L(0); PG8_BAR; PG8_MMA(1, 0, At, B0); PG8_MMA(1, 1, At, B1); PG8_BAR; PG8_SCHED;
            } else {
            PG8_LDB(B0, 0, 0); PG8_SCHED; PG8_LDA(At, 0, 0); PG8_STAGE(PG8_SA(1, 1), a1 + hstep, voffA);
            PG8_WAIT_L(8); PG8_BAR; PG8_WAIT_L(0); PG8_MMA(0, 0, At, B0); PG8_BAR; PG8_SCHED;
            PG8_LDB(B1, 0, 1); PG8_STAGE(PG8_SB(0, 0), b2, voffB);
            PG8_BAR; PG8_WAIT_L(0); PG8_MMA(0, 1, At, B1); PG8_BAR;
            PG8_LDA(At, 0, 1); PG8_STAGE(PG8_SA(0, 0), a2, voffA);
            PG8_BAR; PG8_WAIT_L(0); PG8_MMA(1, 0, At, B0); PG8_BAR; PG8_SCHED;
            PG8_STAGE(PG8_SB(0, 1), b2 + hstep, voffB);
            PG8_WAIT_V(6); PG8_BAR; PG8_MMA(1, 1, At, B1); PG8_BAR;
            PG8_LDB(B0, 1, 0); PG8_SCHED; PG8_LDA(At, 1, 0); PG8_STAGE(PG8_SA(0, 1), a2 + hstep, voffA);
            PG8_WAIT_L(8); PG8_BAR; PG8_WAIT_L(0); PG8_MMA(0, 0, At, B0); PG8_BAR; PG8_SCHED;
            PG8_LDB(B1, 1, 1); PG8_STAGE(PG8_SB(1, 0), b3, voffB);
            PG8_BAR; PG8_WAIT_L(0); PG8_MMA(0, 1, At, B1); PG8_BAR;
            PG8_LDA(At, 1, 1); PG8_STAGE(PG8_SA(1, 0), a3, voffA);
            PG8_BAR; PG8_WAIT_L(0); PG8_MMA(1, 0, At, B0); PG8_BAR; PG8_SCHED;
            PG8_STAGE(PG8_SB(1, 1), b3 + hstep, voffB);
            PG8_WAIT_V(6); PG8_BAR; PG8_MMA(1, 1, At, B1); PG8_BAR;
            }
        }
        if constexpr (ALIGN_EPI) { if (wr == 0) PG8_BAR; }
        if constexpr (!Epi::AFTER_DRAIN) { E(acc, cur, wr, wc, fr, fq); S.done(cur); }
        if (!has_next) break;
#pragma unroll
        for (int a = 0; a < 2; ++a)
#pragma unroll
            for (int b = 0; b < 2; ++b)
#pragma unroll
                for (int m = 0; m < 4; ++m)
#pragma unroll
                    for (int n = 0; n < 2; ++n) acc[a][b][m][n] = (f32x4){0.f, 0.f, 0.f, 0.f};
        cur = nxt; cA = nA; cB = nB; ++ui;
        if constexpr (ALIGN_EPI) { if (wr == 1) PG8_BAR; }
    }
    PG8_WAIT_V(0);
    if constexpr (!ALIGN_EPI) { if (wr == 0) PG8_BAR; }
    PG8_BAR;
    if constexpr (Epi::AFTER_DRAIN) { E.fused(acc, cur, wr, wc, fr, fq, lds, wid, lane); S.done(cur); }
#undef PG8_SA
#undef PG8_SB
#undef PG8_STAGE
#undef PG8_LDA
#undef PG8_LDB
#undef PG8_MMA
#undef PG8_WAIT_V
#undef PG8_WAIT_L
#undef PG8_BAR
#undef PG8_SCHED
}
}
__device__ __forceinline__ void transpose_item(const float* __restrict__ W, int N, bf16_t* __restrict__ WT, int ldt, LAS float* scr, int k0, int n0, int dest_row0,
                                               const float* __restrict__ gain, float mul, int lane) {
    f32x4 v[8];
#pragma unroll
    for (int i = 0; i < 8; ++i) { const int pp = lane + 64 * i, kk = pp >> 3, c4 = pp & 7; v[i] = *(const f32x4*)(W + (size_t)(k0 + kk) * N + n0 + 4 * c4); }
#pragma unroll
    for (int i = 0; i < 8; ++i) { const int pp = lane + 64 * i, kk = pp >> 3, c4 = pp & 7; const float g = gain ? gain[k0 + kk] * mul : mul;
        LAS float* d = scr + kk * 33 + 4 * c4; d[0] = v[i][0] * g; d[1] = v[i][1] * g; d[2] = v[i][2] * g; d[3] = v[i][3] * g; }
    LDS_WAIT(); asm volatile("" ::: "memory");
    const int c = lane & 7;
#pragma unroll
    for (int j = 0; j < 4; ++j) { const int n = (lane >> 3) + 8 * j; const LAS float* s = scr + (8 * c) * 33 + n;
        u32x4 o; o.x = cvt_pk(s[0 * 33], s[1 * 33]); o.y = cvt_pk(s[2 * 33], s[3 * 33]); o.z = cvt_pk(s[4 * 33], s[5 * 33]); o.w = cvt_pk(s[6 * 33], s[7 * 33]);
        *(u32x4*)(WT + (size_t)(dest_row0 + n) * ldt + k0 + 8 * c) = o; }
    LDS_WAIT(); asm volatile("" ::: "memory");
}
__device__ __forceinline__ int permcol(int n) {
    if (n < 2048) return n;
    if (n < 3072) return 5376 + (n - 2048);
    if (n < 4096) return 2048 + (n - 3072);
    if (n < 5120) return 3072 + (n - 4096);
    if (n < 5376) return 4096 + (n - 5120);
    if (n < 5632) return 6400 + (n - 5376);
    return 4352 + (n - 5632);
}
__device__ __forceinline__ void cache_copy(const float* __restrict__ src, float* __restrict__ dstf, bf16_t* __restrict__ dstb, int rows, int rowlen, int gtid, int gthreads) {
    const int per_b = rows * rowlen, n4 = 8 * per_b / 4;
    for (int i4 = gtid; i4 < n4; i4 += gthreads) {
        const int e = i4 * 4, b = e / per_b, rem = e - b * per_b, r = rem / rowlen;
        const f32x4 v = *(const f32x4*)(src + e);
        if (dstb) { u32x2 w; w.x = cvt_pk(v[0], v[1]); w.y = cvt_pk(v[2], v[3]); *(u32x2*)(dstb + e) = w; }
        if (r >= 64) *(f32x4*)(dstf + (size_t)b * per_b + rem - 64 * rowlen) = v;
    }
}
__device__ __forceinline__ void phase0(const Params& p, LAS unsigned char* lds) {
    int tid_ = threadIdx.x; asm volatile("" : "+v"(tid_));
    const int tid = tid_, lane = tid & 63, wave = __builtin_amdgcn_readfirstlane(tid >> 6);
    LAS float* scr = (LAS float*)(lds + wave * 16384);
    const int gw = blockIdx.x * 8 + wave, NGW = gridDim.x * 8;
    unsigned char* ws = p.ws;
    bf16_t* W1T = (bf16_t*)(ws + WS_W1T); bf16_t* W2T = (bf16_t*)(ws + WS_W2T);
    constexpr int I_W1 = 32 * 208, I_W2 = 32 * 64;
    if (wave < 2) for (int it = blockIdx.x * 2 + wave; it < I_W1 + I_W2; it += gridDim.x * 2) {
        int r = it;
        if (r < I_W1) { const int kb = r / 208, nb = r % 208, n0 = nb * 32; const bool isq = (n0 < 1024) || (n0 >= 4096 && n0 < 5120);
            transpose_item(p.in[7], 6656, W1T, 2048, scr, kb * 64, n0, permcol(n0), p.in[6], isq ? C2 : 1.0f, lane); continue; }
        r -= I_W1;
        { const int kb = r / 64, nb = r % 64; transpose_item(p.in[10], 2048, W2T, 2048, scr, kb * 64, nb * 32, nb * 32, nullptr, 1.0f, lane); }
    }
    bf16_t* XB = (bf16_t*)(ws + WS_XB);
    if (wave >= 2) for (int m = blockIdx.x * 6 + (wave - 2); m < NTOK; m += gridDim.x * 6) {
        const float* xrow = (m < NTOKP) ? p.in[0] + (size_t)m * DM : p.in[1] + (size_t)(m - NTOKP) * DM;
        const f32x4* xr = (const f32x4*)xrow + lane;
        f32x4 v[8]; float s = 0.f;
#pragma unroll
        for (int j = 0; j < 8; ++j) { v[j] = xr[64 * j]; s += (v[j][0] * v[j][0] + v[j][1] * v[j][1]) + (v[j][2] * v[j][2] + v[j][3] * v[j][3]); }
        s = wave_sum(s);
        const float rr = 1.0f / sqrtf(s * (1.0f / DM) + RMS_EPS);
        u32x2* o8 = (u32x2*)(XB + (size_t)m * DM) + lane;
#pragma unroll
        for (int j = 0; j < 8; ++j) { u32x2 w; w.x = cvt_pk(v[j][0] * rr, v[j][1] * rr); w.y = cvt_pk(v[j][2] * rr, v[j][3] * rr); o8[64 * j] = w; }
    }
    const int gtid = blockIdx.x * 512 + tid, gthreads = gridDim.x * 512;
    for (int i = gtid; i < 16 * 320; i += gthreads) ((float*)(ws + WS_TAB))[i] = p.in[8][i] * LOG2E;
    if (gtid < 16) ((float*)(ws + WS_SINK))[gtid] = p.in[9][gtid] * LOG2E;
    for (int i = gtid; i < DM; i += gthreads) ((float*)(ws + WS_GF))[i] = p.in[11][i];
    for (int i = gtid; i < 512 * DM / 4; i += gthreads) ((f32x4*)(ws + WS_XS))[i] = ((const f32x4*)p.in[1])[i];
}

__device__ __forceinline__ void cache_phase(LAS unsigned char* lds, int w, int nw) {
    int tid_ = threadIdx.x; asm volatile("" : "+v"(tid_));
    const int tid = tid_, lane = tid & 63, wave = __builtin_amdgcn_readfirstlane(tid >> 6);
    kparams_t kp = fresh_params(); unsigned char* ws = kp->ws; float* out = kp->out;
    const float* cak = kp->in[2]; const float* cav = kp->in[3]; const float* cbk = kp->in[4]; const float* cbv = kp->in[5];
    LAS float* scr = (LAS float*)(lds + wave * 16384);
    constexpr int I_CAV = 8 * 8 * 32, I_CBV = 8 * 2 * 8;
    for (int r = w * 8 + wave; r < I_CAV + I_CBV; r += nw * 8) {
        if (r < I_CAV) { const int b = r >> 8, q = r & 255, kb = q >> 5, nb = q & 31;
            transpose_item(cav + (size_t)b * 512 * 1024, 1024, (bf16_t*)(ws + WS_CAVT) + (size_t)b * 1024 * 512, 512, scr, kb * 64, nb * 32, nb * 32, nullptr, 1.0f, lane); }
        else { const int r2 = r - I_CAV, b = r2 >> 4, q = r2 & 15, kb = q >> 3, nb = q & 7;
            transpose_item(cbv + (size_t)b * 128 * 256, 256, (bf16_t*)(ws + WS_CBVT) + (size_t)b * 256 * 128, 128, scr, kb * 64, nb * 32, nb * 32, nullptr, 1.0f, lane); }
    }
    const int gtid = w * 512 + tid, gthreads = nw * 512;
    cache_copy(cak, out + OFF_AKS, (bf16_t*)(ws + WS_CAK), 512, 1024, gtid, gthreads);
    cache_copy(cav, out + OFF_AVS, nullptr, 512, 1024, gtid, gthreads);
    cache_copy(cbk, out + OFF_BKS, (bf16_t*)(ws + WS_CBK), 128, 256, gtid, gthreads);
    cache_copy(cbv, out + OFF_BVS, nullptr, 128, 256, gtid, gthreads);
}

#define MFMA32(a, b, c) __builtin_amdgcn_mfma_f32_32x32x16_bf16((a), (b), (c), 0, 0, 0)
__device__ __forceinline__ float ex2(float x) { return __builtin_amdgcn_exp2f(x); }
constexpr int AT_BUFB = 70656, AT_VROW = 144, AT_TAB = 2 * AT_BUFB;

template <int HG>
__device__ __forceinline__ void at_load(u32x4 (&kr)[HG], u32x4 (&vr)[HG], const bf16_t* __restrict__ Kb, int kstr, size_t khs, const bf16_t* __restrict__ Vb, int vstr, int tid) {
#pragma unroll
    for (int i = 0; i < HG; ++i) { const int pp = tid + 512 * i; const int row = pp / (HG * 8), c16 = pp % (HG * 8);
        kr[i] = *(const u32x4*)(Kb + (size_t)(c16 >> 3) * khs + (size_t)row * kstr + (c16 & 7) * 8); }
#pragma unroll
    for (int i = 0; i < HG; ++i) { const int pp = tid + 512 * i; const int row = pp >> 3, c16 = pp & 7;
        vr[i] = *(const u32x4*)(Vb + (size_t)row * vstr + c16 * 8); }
}
template <int HG>
__device__ __forceinline__ void at_store(const u32x4 (&kr)[HG], const u32x4 (&vr)[HG], LAS unsigned char* buf, int tid) {
    constexpr int RS = HG * 128 + 16, KB = 64 * RS;
#pragma unroll
    for (int i = 0; i < HG; ++i) { const int pp = tid + 512 * i; const int row = pp / (HG * 8), c16 = pp % (HG * 8);
        *(LAS u32x4*)(buf + row * RS + c16 * 16) = kr[i]; }
#pragma unroll
    for (int i = 0; i < HG; ++i) { const int pp = tid + 512 * i; const int row = pp >> 3, c16 = pp & 7;
        LAS unsigned char* d = buf + KB + row * AT_VROW + ((c16 & ~1) * 2 + (c16 & 1)) * 8;
        *(LAS u32x2*)(d) = (u32x2){vr[i].x, vr[i].y}; *(LAS u32x2*)(d + 16) = (u32x2){vr[i].z, vr[i].w}; }
}

template <bool ISA, int HG>
__device__ __forceinline__ void attn_tile(const LAS unsigned char* buf, int hl, const bf16x8 (&q)[4], f32x16& o0, f32x16& o1, float& m, float& l,
                                          int bias_base, bool cbias, float cval, float slope2, const LAS float* tab, int r32, int hi) {
    constexpr int RS = HG * 128 + 16, KB = 64 * RS;
    const LAS unsigned char* kp = buf + r32 * RS + (hl * 64 + 8 * hi) * 2;
    bf16x8 k0[4], k1[4];
#pragma unroll
    for (int d0 = 0; d0 < 4; ++d0) { k0[d0] = *(const LAS bf16x8*)(kp + 32 * d0); k1[d0] = *(const LAS bf16x8*)(kp + 32 * RS + 32 * d0); }
    f32x16 s0, s1;
    if (ISA) {
        if (cbias) {
#pragma unroll
            for (int r = 0; r < 16; ++r) { s0[r] = 0.f; s1[r] = 0.f; }
        } else {
            const LAS float* tb = tab + (383 - bias_base);
#pragma unroll
            for (int r = 0; r < 16; ++r) { const int off = (r & 3) + 8 * (r >> 2); s0[r] = tb[off]; s1[r] = tb[off + 32]; }
        }
    } else {
#pragma unroll
        for (int r = 0; r < 16; ++r) { const int off = (r & 3) + 8 * (r >> 2); const int d = bias_base - off;
            s0[r] = -slope2 * fabsf((float)d); s1[r] = -slope2 * fabsf((float)(d - 32)); }
    }
#pragma unroll
    for (int d0 = 0; d0 < 4; ++d0) { s0 = MFMA32(k0[d0], q[d0], s0); s1 = MFMA32(k1[d0], q[d0], s1); }
    float mx;
    { float m4[4];
#pragma unroll
      for (int k = 0; k < 4; ++k) { m4[k] = fmaxf(fmaxf(s0[k], s1[k]), s0[k + 4]); m4[k] = fmaxf(fmaxf(m4[k], s1[k + 4]), s0[k + 8]); m4[k] = fmaxf(fmaxf(m4[k], s1[k + 8]), s0[k + 12]); m4[k] = fmaxf(m4[k], s1[k + 12]); }
      mx = fmaxf(fmaxf(m4[0], m4[1]), fmaxf(m4[2], m4[3])); }
    { auto rr = __builtin_amdgcn_permlane32_swap(__float_as_uint(mx), __float_as_uint(mx), false, false); mx = fmaxf(__uint_as_float(rr[0]), __uint_as_float(rr[1])); }
    const float csh = (ISA && cbias) ? cval : 0.f;
    mx += csh;
    if (__builtin_amdgcn_ballot_w64(mx > m + 8.0f) != 0ull) {
        const float mn = fmaxf(m, mx), alpha = ex2(m - mn); m = mn; l *= alpha;
#pragma unroll
        for (int r = 0; r < 16; ++r) { o0[r] *= alpha; o1[r] *= alpha; }
    }
    { const float mr = m - csh;
#pragma unroll
      for (int r = 0; r < 16; ++r) { s0[r] = ex2(s0[r] - mr); s1[r] = ex2(s1[r] - mr); } }
    { float a4[4];
#pragma unroll
      for (int k = 0; k < 4; ++k) {
          float t0 = s0[k] + s1[k], t1 = s0[k + 4] + s1[k + 4], t2 = s0[k + 8] + s1[k + 8], t3 = s0[k + 12] + s1[k + 12];
          asm volatile("" : "+v"(t0), "+v"(t1), "+v"(t2), "+v"(t3));
          float u0 = t0 + t1, u1 = t2 + t3; asm volatile("" : "+v"(u0), "+v"(u1));
          a4[k] = u0 + u1; asm volatile("" : "+v"(a4[k])); }
      float w0 = a4[0] + a4[1], w1 = a4[2] + a4[3]; asm volatile("" : "+v"(w0), "+v"(w1));
      l += w0 + w1; }
    bf16x8 pf[4];
#pragma unroll
    for (int ks = 0; ks < 4; ++ks) { u32x4 w;
        if (ks < 2) { const int b = 8 * ks; w.x = cvt_pk(s0[b], s0[b + 1]); w.y = cvt_pk(s0[b + 2], s0[b + 3]); w.z = cvt_pk(s0[b + 4], s0[b + 5]); w.w = cvt_pk(s0[b + 6], s0[b + 7]); }
        else { const int b = 8 * (ks - 2); w.x = cvt_pk(s1[b], s1[b + 1]); w.y = cvt_pk(s1[b + 2], s1[b + 3]); w.z = cvt_pk(s1[b + 4], s1[b + 5]); w.w = cvt_pk(s1[b + 6], s1[b + 7]); }
        pf[ks] = __builtin_bit_cast(bf16x8, w); }
    __builtin_amdgcn_sched_barrier(0);
    const LAS unsigned char* vp0 = buf + KB + (hl * 64 + r32) * AT_VROW + 16 * hi;
    const LAS unsigned char* vp1 = vp0 + 32 * AT_VROW;
    u32x4 va[2][4];
#pragma unroll
    for (int ks = 0; ks < 4; ++ks) { va[0][ks] = *(const LAS u32x4*)(vp0 + 32 * ks); va[1][ks] = *(const LAS u32x4*)(vp1 + 32 * ks); }
    __builtin_amdgcn_sched_barrier(0);
#pragma unroll
    for (int ks = 0; ks < 4; ++ks) {
        o0 = MFMA32(__builtin_bit_cast(bf16x8, va[0][ks]), pf[ks], o0); o1 = MFMA32(__builtin_bit_cast(bf16x8, va[1][ks]), pf[ks], o1); }
}

template <bool ISA>
__device__ __forceinline__ void attn_stream(unsigned char* ws, int vb, LAS unsigned char* lds, int tid, int lane, int wave) {
    constexpr int HG = ISA ? 4 : 1, NP = ISA ? 8 : 2;
    const int r32 = lane & 31, hi = lane >> 5;
    const bf16_t* Z = (const bf16_t*)(ws + WS_Z); const bf16_t* VT = (const bf16_t*)(ws + WS_VT); bf16_t* O = (bf16_t*)(ws + WS_O);
    const int gidx = vb & 3, ubase = 32 * ((vb >> 2) & 1) + (vb >> 3);
    const int hl = ISA ? (wave >> 1) : 0, h = gidx * 4 + (wave >> 1), qblk = wave & 1;
    const int i = qblk * 32 + r32;
    const int qcol = ISA ? h * 64 : 3072 + h * 64, gcol = ISA ? 2048 + h * 64 : 4352 + h * 64, ocol = ISA ? h * 64 : 1024 + h * 64;
    const int kcol = ISA ? 1024 + gidx * 256 : 4096 + gidx * 64, vrow = ISA ? gidx * 256 : 1024 + gidx * 64;
    LAS float* tab = (LAS float*)(lds + AT_TAB) + wave * 384;
    u32x4 kr[HG], vr[HG];
#define AT_J0(uu) (((uu) >= 512) ? 0 : ((((uu) & 255) < NP) ? NP - ((uu) & 255) : 0))
#define AT_SRC(uu, j, Kb, kstr, Vb, vstr) \
    const bf16_t* Kb; int kstr; size_t khs; const bf16_t* Vb; int vstr; \
    if ((uu) >= 512 && (j) < NP) { const int b_ = (uu) - 512; \
        if (ISA) { Kb = (const bf16_t*)(ws + WS_CAK) + ((size_t)(b_ * 512 + (j) * 64) * 1024 + gidx * 256); kstr = 1024; khs = 64; \
                   Vb = (const bf16_t*)(ws + WS_CAVT) + ((size_t)(b_ * 1024 + gidx * 256) * 512 + (j) * 64); vstr = 512; } \
        else     { Kb = (const bf16_t*)(ws + WS_CBK) + ((size_t)(b_ * 128 + (j) * 64) * 256 + gidx * 64); kstr = 256; khs = 64; \
                   Vb = (const bf16_t*)(ws + WS_CBVT) + ((size_t)(b_ * 256 + gidx * 64) * 128 + (j) * 64); vstr = 128; } \
    } else { const size_t R = (size_t)((uu) - NP + (j)) * 64; Kb = Z + ((size_t)(kcol >> 6) * NTOK + R) * 64; kstr = 64; khs = ZHS; Vb = VT + ((size_t)((uu) - NP + (j)) * NVC + vrow) * 64; vstr = 64; }
    { const int jf = AT_J0(ubase); AT_SRC(ubase, jf, Kb, kstr, Vb, vstr); at_load<HG>(kr, vr, Kb, kstr, khs, Vb, vstr, tid); }
    bf16x8 q[4];
    { const bf16_t* qp = Z + ((size_t)(qcol >> 6) * NTOK + (size_t)ubase * 64 + i) * 64 + 8 * hi;
#pragma unroll
      for (int d0 = 0; d0 < 4; ++d0) q[d0] = *(const bf16x8*)(qp + 16 * d0); }
    float slope2 = 0.f, cval = 0.f, sink2 = 0.f;
    if (ISA) { const float* rb = (const float*)(ws + WS_TAB) + h * 320;
#pragma unroll
        for (int k = 0; k < 6; ++k) { const int t = lane + 64 * k, idx = 383 - t; tab[t] = rb[idx < 319 ? idx : 319]; }
        cval = rb[319]; }
    else { slope2 = exp2f(-0.5f * (float)(h + 1)) * LOG2E; sink2 = ((const float*)(ws + WS_SINK))[h]; }
    int cur = 0;
    for (int u = ubase; u < 520; u += 64) {
        const size_t qrow = (size_t)u * 64 + i;
        const int un = u + 64; const bool has_next = un < 520;
        at_store<HG>(kr, vr, lds + cur * AT_BUFB, tid);
        __syncthreads();
        f32x16 o0, o1;
#pragma unroll
        for (int r = 0; r < 16; ++r) { o0[r] = 0.f; o1[r] = 0.f; }
        float m = -1e30f, l = 0.f;
        asm volatile("" :: "v"(q[0]), "v"(q[1]), "v"(q[2]), "v"(q[3]), "v"(cval), "v"(slope2), "v"(sink2));
        for (int j = AT_J0(u); j < NP; ++j) {
            { AT_SRC(u, j + 1, Kb, kstr, Vb, vstr); at_load<HG>(kr, vr, Kb, kstr, khs, Vb, vstr, tid); }
            const int bias_base = (ISA ? 575 : 128) + i - 64 * j - 4 * hi;
            attn_tile<ISA, HG>(lds + cur * AT_BUFB, hl, q, o0, o1, m, l, bias_base, j < 4, cval, slope2, tab, r32, hi);
            at_store<HG>(kr, vr, lds + (cur ^ 1) * AT_BUFB, tid);
            __syncthreads();
            cur ^= 1;
        }
        u32x2 gv[8]; bf16x8 qn[4];
        { const bf16_t* gp = Z + ((size_t)(gcol >> 6) * NTOK + qrow) * 64 + 4 * hi;
#pragma unroll
          for (int t = 0; t < 8; ++t) gv[t] = *(const u32x2*)(gp + (t >> 2) * 32 + 8 * (t & 3));
          const bf16_t* qp = Z + ((size_t)(qcol >> 6) * NTOK + qrow + (has_next ? 4096 : 0)) * 64 + 8 * hi;
#pragma unroll
          for (int d0 = 0; d0 < 4; ++d0) qn[d0] = *(const bf16x8*)(qp + 16 * d0); }
        { const int uu = has_next ? un : u; const int jn = AT_J0(uu); AT_SRC(uu, jn, Kb, kstr, Vb, vstr); at_load<HG>(kr, vr, Kb, kstr, khs, Vb, vstr, tid); }
        { int bias_base = (ISA ? 575 : 128) + i - 64 * NP - 4 * hi; asm volatile("" : "+v"(bias_base));
          attn_tile<ISA, HG>(lds + cur * AT_BUFB, hl, q, o0, o1, m, l, bias_base, false, cval, slope2, tab, r32, hi); }
        __syncthreads();
        cur ^= 1;
        const float lt = l + __shfl_xor(l, 32);
        float scale;
        if (ISA) scale = 1.0f / lt;
        else { const float mf = fmaxf(m, sink2), a = ex2(m - mf); scale = a / (lt * a + ex2(sink2 - mf)); }
        bf16_t* op = O + qrow * DM + ocol + 4 * hi;
#pragma unroll
        for (int t = 0; t < 8; ++t) {
            const int dblk = t >> 2, g = t & 3;
            float gg[4] = {__uint_as_float(gv[t].x << 16), __uint_as_float(gv[t].x & 0xffff0000u), __uint_as_float(gv[t].y << 16), __uint_as_float(gv[t].y & 0xffff0000u)};
            float ov[4];
#pragma unroll
            for (int e = 0; e < 4; ++e) { const float x = gg[e], sg = x * __builtin_amdgcn_rcpf(1.0f + ex2(-x * LOG2E));
                ov[e] = (dblk ? o1[4 * g + e] : o0[4 * g + e]) * scale * sg; }
            u32x2 w; w.x = cvt_pk(ov[0], ov[1]); w.y = cvt_pk(ov[2], ov[3]);
            *(u32x2*)(op + dblk * 32 + 8 * g) = w;
        }
#pragma unroll
        for (int d0 = 0; d0 < 4; ++d0) q[d0] = qn[d0];
    }
#undef AT_SRC
#undef AT_J0
}
__device__ __forceinline__ void attn_phase(const Params& p, LAS unsigned char* lds) {
    int tid_ = threadIdx.x; asm volatile("" : "+v"(tid_));
    const int tid = tid_, lane = tid & 63, wave = __builtin_amdgcn_readfirstlane(tid >> 6);
    const int G = gridDim.x, bx = blockIdx.x;
    unsigned char* ws = fresh_params()->ws;
    for (int vb = bx; vb < 256; vb += G) attn_stream<true>(ws, vb, lds, tid, lane, wave);
    for (int vb = bx; vb < 256; vb += G) attn_stream<false>(ws, 255 - vb, lds, tid, lane, wave);
}

__device__ __forceinline__ void phase4(const Params& p) {
    int tid_ = threadIdx.x; asm volatile("" : "+v"(tid_));
    const int tid = tid_, lane = tid & 63, wave = __builtin_amdgcn_readfirstlane(tid >> 6);
    const int gw = blockIdx.x * 8 + wave, NGW = gridDim.x * 8;
    kparams_t kp = fresh_params(); unsigned char* ws4 = kp->ws; float* out4 = kp->out;
    const float* pss = (const float*)(ws4 + WS_PSS);
    f32x4 g[8];
#pragma unroll
    for (int j = 0; j < 8; ++j) g[j] = ((const f32x4*)(ws4 + WS_GF))[lane + 64 * j];
    for (int m = NTOKP + gw; m < NTOK; m += NGW) {
        const f32x4* ys = (const f32x4*)((const float*)(ws4 + WS_XS) + (size_t)(m - NTOKP) * DM) + lane;
        f32x4 v[8]; float s = 0.f;
#pragma unroll
        for (int j = 0; j < 8; ++j) v[j] = ys[64 * j];
#pragma unroll 1
        for (int ks = 0; ks < 8; ++ks) { const f32x4* ps = (const f32x4*)((const float*)(ws4 + WS_PS) + ((size_t)ks * 512 + (m - NTOKP)) * DM) + lane;
#pragma unroll
            for (int j = 0; j < 8; ++j) v[j] += ps[64 * j]; }
#pragma unroll
        for (int j = 0; j < 8; ++j) s += (v[j][0] * v[j][0] + v[j][1] * v[j][1]) + (v[j][2] * v[j][2] + v[j][3] * v[j][3]);
        s = wave_sum(s);
        const float r = 1.0f / sqrtf(s * (1.0f / DM) + RMS_EPS);
        f32x4* y = (f32x4*)(out4 + (size_t)m * DM) + lane;
#pragma unroll
        for (int j = 0; j < 8; ++j) y[64 * j] = v[j] * r * g[j];
    }
    for (int m = gw; m < NTOKP; m += NGW) {
        float s = (lane < 32) ? pss[(size_t)m * 32 + lane] : 0.f;
        s = wave_sum(s);
        const float r = 1.0f / sqrtf(s * (1.0f / DM) + RMS_EPS);
        const u32x2* yb = (const u32x2*)((const bf16_t*)(ws4 + WS_Z) + (size_t)m * DM) + lane;
        f32x4* y = (f32x4*)(out4 + (size_t)m * DM) + lane;
        u32x2 t[8];
#pragma unroll
        for (int j = 0; j < 8; ++j) t[j] = yb[64 * j];
#pragma unroll
        for (int j = 0; j < 8; ++j) { f32x4 v = {__uint_as_float(t[j].x << 16), __uint_as_float(t[j].x & 0xffff0000u), __uint_as_float(t[j].y << 16), __uint_as_float(t[j].y & 0xffff0000u)};
            y[64 * j] = v * r * g[j]; }
    }
}

#ifndef MK_N_LAUNCHES
#define MK_N_LAUNCHES 1
#endif
__global__ void __launch_bounds__(512, 2) mk_fwd(Params p) {
    extern __shared__ __attribute__((aligned(16))) unsigned char lds_raw[];
    LAS unsigned char* lds = (LAS unsigned char*)lds_raw;
    unsigned char* ws = p.ws;
#ifndef PH_MASK
#define PH_MASK 31
#endif
#if MK_N_LAUNCHES == 1
#define IN(k) ((PH_MASK >> (k)) & 1)
#else
#define IN(k) (((PH_MASK >> (k)) & 1) && p.ph_lo <= (k) && (k) < p.ph_hi)
#endif
#ifndef REP_MASK
#define REP_MASK 0
#endif
#define REPS(k) (((REP_MASK >> (k)) & 1) ? 2 : 1)
#define GSYNC0() cg::this_grid().sync()
#define GSYNC() do { XcdBarrier xb_; xb_.bar = (unsigned*)(fresh_params()->ws + WS_BAR); xb_.x = xb_xcc_id(); xb_.st = (volatile LAS unsigned*)(lds + MISC_OFF); xcd_barrier(xb_); } while (0)
    if (threadIdx.x < 2) ((volatile LAS unsigned*)(lds + MISC_OFF))[threadIdx.x] = 0u;
    __syncthreads();
    if (blockIdx.x == 0) for (int i = threadIdx.x; i < XCD_BAR_WORDS; i += 512) ((unsigned*)(ws + WS_BAR))[i] = 0u;
    GSYNC0();
    (void)xcd_barrier_post((unsigned*)(fresh_params()->ws + WS_BAR), (volatile LAS unsigned*)(lds + MISC_OFF));
    if (IN(0)) for (int rep = 0; rep < REPS(0); ++rep) { phase0(p, lds); GSYNC(); }
    if (IN(1)) for (int rep = 0; rep < REPS(1); ++rep) {
        { pg8::Gemm g{(const bf16_t*)(ws + WS_XB), (const bf16_t*)(ws + WS_W1T), NTOK, LDZ, DM, DM}; pg8::StaticOrder S; S.init(NTOK, LDZ, (int)gridDim.x, (int)blockIdx.x);
          pg8::EpiZ E{(bf16_t*)(ws + WS_Z), (const float*)(ws + WS_RS), p.out};
          pg8::gemm_phase<pg8::EpiZ, pg8::StaticOrder, true, true>(lds, g, S, E); }
        { pg8::Gemm g{(const bf16_t*)(ws + WS_W1T) + (size_t)LDZ * DM, (const bf16_t*)(ws + WS_XB), NVC, NTOK, DM, DM}; pg8::StaticOrder S; S.init(NVC, NTOK, (int)gridDim.x, (int)(gridDim.x - 1 - blockIdx.x));
          pg8::EpiVt E{(bf16_t*)(ws + WS_VT), (const float*)(ws + WS_RS), p.out};
          pg8::gemm_phase<pg8::EpiVt, pg8::StaticOrder, true, true>(lds, g, S, E); }
        { const int G = (int)gridDim.x, bx = (int)blockIdx.x;
          if (G == 256) { if (bx < 118) cache_phase(lds, bx, 204); else if (bx >= 170) cache_phase(lds, bx - 52, 204); }
          else cache_phase(lds, bx, G); }
        GSYNC();
    }
    if (IN(2)) for (int rep = 0; rep < REPS(2); ++rep) { attn_phase(p, lds); GSYNC(); }
    for (int rep = 0; rep < REPS(3); ++rep) {
    if (IN(3)) {
        kparams_t kp = fresh_params(); unsigned char* ws = kp->ws;
        { pg8::Gemm g{(const bf16_t*)(ws + WS_O), (const bf16_t*)(ws + WS_W2T), NTOKP, DM, DM, DM}; pg8::StaticOrder S; S.init(NTOKP, DM, (int)gridDim.x, (int)blockIdx.x);
          pg8::EpiY E{kp->in[0], (const float*)(ws + WS_XS), (bf16_t*)(ws + WS_Z), (float*)(ws + WS_PSS)};
          pg8::gemm_phase<pg8::EpiY, pg8::StaticOrder, true, true>(lds, g, S, E); }
        { pg8::Gemm g{(const bf16_t*)(ws + WS_O), (const bf16_t*)(ws + WS_W2T), NTOK, DM, 256, DM}; pg8::SplitK8 S{(int)gridDim.x, (int)(gridDim.x - 1 - blockIdx.x)};
          pg8::EpiYS E{(float*)(ws + WS_PS)};
          pg8::gemm_phase<pg8::EpiYS, pg8::SplitK8, false, true>(lds, g, S, E); }
        GSYNC();
    }
    if (IN(4)) { phase4(p); if (rep + 1 < REPS(3)) GSYNC(); }
    }
#undef IN
}

extern "C" void kernel_launch(void* const* d_in, const int* in_sizes, int n_in, void* d_out, int out_size, void* d_ws, size_t ws_size, hipStream_t stream) {
    static int grid = 0;
    if (grid == 0) {
        if (n_in != 12 || ws_size < WS_END) { fprintf(stderr, "kernel_launch: bad arguments (n_in %d, ws %zu < %zu)\n", n_in, ws_size, (size_t)WS_END); grid = -1; return; }
        int dev = 0, cus = 0, per_cu = 0;
        if (hipGetDevice(&dev) != hipSuccess || hipDeviceGetAttribute(&cus, hipDeviceAttributeMultiprocessorCount, dev) != hipSuccess) { grid = -1; return; }
        if (hipFuncSetAttribute((const void*)mk_fwd, hipFuncAttributeMaxDynamicSharedMemorySize, LDS_BYTES) != hipSuccess) { fprintf(stderr, "kernel_launch: hipFuncSetAttribute failed\n"); grid = -1; return; }
        if (hipOccupancyMaxActiveBlocksPerMultiprocessor(&per_cu, (const void*)mk_fwd, 512, LDS_BYTES) != hipSuccess || per_cu < 1) { fprintf(stderr, "kernel_launch: occupancy query failed (%d)\n", per_cu); grid = -1; return; }
        grid = cus * per_cu;
    }
    if (grid < 0) return;
    Params p{};
    for (int i = 0; i < 12; ++i) p.in[i] = (const float*)d_in[i];
    p.out = (float*)d_out; p.ws = (unsigned char*)d_ws;
#if MK_N_LAUNCHES == 1
    p.ph_lo = 0; p.ph_hi = 5;
    void* args[] = {&p};
    hipError_t e = hipLaunchCooperativeKernel((const void*)mk_fwd, dim3(grid), dim3(512), args, LDS_BYTES, stream);
    if (e != hipSuccess) fprintf(stderr, "cooperative launch failed: %s (grid %d)\n", hipGetErrorString(e), grid);
#else
    for (int li = 0; li < 5; ++li) { p.ph_lo = li; p.ph_hi = li + 1; hipLaunchKernelGGL(mk_fwd, dim3(grid), dim3(512), LDS_BYTES, stream, p); }
#endif
}
```

```cpp
#include <hip/hip_runtime.h>
#include <hip/hip_cooperative_groups.h>
#include <cstdio>
#include <cstdint>
namespace cg = cooperative_groups;

#define LAS __attribute__((address_space(3)))
typedef unsigned short bf16_t;
typedef short bf16x8 __attribute__((ext_vector_type(8)));
typedef float f32x4 __attribute__((ext_vector_type(4)));
typedef float f32x16 __attribute__((ext_vector_type(16)));
typedef unsigned u32x4 __attribute__((ext_vector_type(4)));
typedef unsigned u32x2 __attribute__((ext_vector_type(2)));

constexpr int DM = 2048, NTOKP = 32768, NTOK = 33280;
constexpr int LDZ = 5376;
constexpr size_t ZHS = (size_t)33280 * 64;
constexpr int NVC = 1280, LDV = NTOK;
constexpr float LOG2E = 1.4426950408889634f;
constexpr float C2 = 0.125f * LOG2E;
constexpr float RMS_EPS = 1e-6f;
constexpr size_t OFF_AKP = 68157440, OFF_AVP = 69206016, OFF_BKP = 70254592, OFF_BVP = 70320128,
                 OFF_AKS = 70385664, OFF_AVS = 74579968, OFF_BKS = 78774272, OFF_BVS = 79036416;
constexpr size_t MiB = 1u << 20;
constexpr size_t WS_XB = 0, WS_O = 0, WS_W1T = 130 * MiB, WS_W2T = 156 * MiB, WS_Z = 164 * MiB, WS_VT = WS_Z + 357826560,
                 WS_CAK = WS_VT + 85196800, WS_CAVT = WS_CAK + 8 * MiB, WS_CBK = WS_CAVT + 8 * MiB, WS_CBVT = WS_CBK + MiB / 2,
                 WS_RS = WS_CBVT + MiB / 2, WS_PSS = WS_RS + MiB, WS_XS = WS_PSS + 5 * MiB, WS_TAB = WS_XS + 4 * MiB, WS_SINK = WS_TAB + 32768, WS_GF = WS_SINK + 4096, WS_PS = WS_GF + 8192, WS_BAR = WS_PS + 32 * MiB, WS_END = WS_BAR + 16384;
constexpr int MISC_OFF = 159744, LDS_BYTES = 159744 + 64;

struct Params { const float* in[12]; float* out; unsigned char* ws; int ph_lo, ph_hi; };

__device__ __forceinline__ unsigned cvt_pk(float lo, float hi) {
    typedef float f2 __attribute__((ext_vector_type(2))); typedef __bf16 b2 __attribute__((ext_vector_type(2)));
    f2 v = {lo, hi}; b2 b = __builtin_convertvector(v, b2); return __builtin_bit_cast(unsigned, b);
}
__device__ __forceinline__ float bf2f(unsigned short b) { return __uint_as_float((unsigned)b << 16); }
__device__ __forceinline__ float wave_sum(float v) {
#pragma unroll
    for (int o = 1; o < 64; o <<= 1) v += __shfl_xor(v, o);
    return v;
}
#define LDS_WAIT() asm volatile("s_waitcnt lgkmcnt(0)" ::: "memory")
typedef const __attribute__((address_space(4))) Params* kparams_t;
__device__ __forceinline__ kparams_t fresh_params() { kparams_t kp = (kparams_t)__builtin_amdgcn_kernarg_segment_ptr(); asm volatile("" : "+s"(kp)); return kp; }

#define XB_TMO      128
#define XB_XCNT(j)  (256  + 64 * (j))
#define XB_XSUB(j)  (1280 + 64 * (j))
#define XB_XGEN(j)  (2304 + 64 * (j))
#define XB_TOP      3328
#define XB_TOPGEN   3392
#define XCD_BAR_WORDS 3456
#define XB_SPIN_CAP (1u << 18)

__device__ __forceinline__ unsigned xb_ld(unsigned* p)              { return __hip_atomic_load(p, __ATOMIC_RELAXED, __HIP_MEMORY_SCOPE_AGENT); }
__device__ __forceinline__ unsigned xb_add(unsigned* p, unsigned v) { return __hip_atomic_fetch_add(p, v, __ATOMIC_RELAXED, __HIP_MEMORY_SCOPE_AGENT); }
__device__ __forceinline__ unsigned xb_xcc_id() { return (unsigned)__builtin_amdgcn_s_getreg((3 << 11) | 20) & 0xFu; }
#define XB_SPIN(cond, bar) do { unsigned _sp = 0; while (cond) { __builtin_amdgcn_s_sleep(1); \
    if ((++_sp & 255u) == 0u) { if (xb_ld(&(bar)[XB_TMO])) break; if (_sp > XB_SPIN_CAP) { atomicAdd(&(bar)[XB_TMO], 1u); break; } } } } while (0)

struct XcdBarrier {
    unsigned* bar; unsigned x;
    volatile LAS unsigned* st;
};

__device__ __forceinline__ XcdBarrier xcd_barrier_post(unsigned* bar, volatile LAS unsigned* st) {
    XcdBarrier b; b.bar = bar; b.x = xb_xcc_id(); b.st = st;
    if (threadIdx.x == 0) (void)xb_add(&bar[XB_XCNT(b.x)], 1u);
    return b;
}
__device__ __forceinline__ void xcd_barrier_complete(unsigned* bar, unsigned x, unsigned& nloc, unsigned& nx) {
    const unsigned G = gridDim.x * gridDim.y * gridDim.z;
    unsigned sum, cnt, mine, sp = 0u;
    for (;;) {
        sum = 0u; cnt = 0u; mine = 0u;
#pragma unroll
        for (unsigned j = 0; j < 16; ++j) { const unsigned c = xb_ld(&bar[XB_XCNT(j)]); sum += c; cnt += (c > 0u) ? 1u : 0u; mine = (j == x) ? c : mine; }
        if (sum == G) break;
        __builtin_amdgcn_s_sleep(1);
        if ((++sp & 255u) == 0u) { if (xb_ld(&bar[XB_TMO])) break; if (sp > XB_SPIN_CAP) { atomicAdd(&bar[XB_TMO], 1u); break; } }
    }
    nloc = mine > 0u ? mine : 1u; nx = cnt > 0u ? cnt : 1u;
}

__device__ __forceinline__ void xcd_barrier(const XcdBarrier& b) {
    asm volatile("s_waitcnt vmcnt(0)" ::: "memory");
    __syncthreads();
    if (threadIdx.x == 0) {
        unsigned* bar = b.bar;
        __builtin_amdgcn_s_waitcnt(0);
        unsigned nloc = b.st[0], nx = b.st[1];
        if (nloc == 0u) { xcd_barrier_complete(bar, b.x, nloc, nx); b.st[0] = nloc; b.st[1] = nx; }
        const unsigned old = xb_add(&bar[XB_XSUB(b.x)], 1u);
        const unsigned gen = old / nloc;
        if (old + 1u == (gen + 1u) * nloc) {
            __builtin_amdgcn_fence(__ATOMIC_RELEASE, "agent");
            asm volatile("s_waitcnt vmcnt(0)" ::: "memory");
            const unsigned og = xb_add(&bar[XB_TOP], 1u);
            const unsigned tg = og / nx;
            if (og + 1u == (tg + 1u) * nx) xb_add(&bar[XB_TOPGEN], 1u);
            else XB_SPIN(xb_ld(&bar[XB_TOPGEN]) == tg, bar);
            __builtin_amdgcn_fence(__ATOMIC_ACQUIRE, "agent");
            xb_add(&bar[XB_XGEN(b.x)], 1u);
            asm volatile("s_waitcnt vmcnt(0)" ::: "memory");
        } else {
            XB_SPIN(xb_ld(&bar[XB_XGEN(b.x)]) == gen, bar);
            __builtin_amdgcn_fence(__ATOMIC_ACQUIRE, "agent");
            asm volatile("s_waitcnt vmcnt(0)" ::: "memory");
        }
    }
    __syncthreads();
}


namespace pg8 {
#define PG8_LAS __attribute__((address_space(3)))
typedef unsigned short bf16_t;
typedef short bf16x8 __attribute__((ext_vector_type(8)));
typedef float f32x4 __attribute__((ext_vector_type(4)));
typedef unsigned u32x4 __attribute__((ext_vector_type(4)));
constexpr int BM = 256, BK = 64, HALF = 128, HTB = HALF * BK * 2  , STAGE_BYTES = 8 * HTB, NXCD = 8, WGM = 8;

__host__ __device__ __forceinline__ int lds_byte(int r, int c) { const int st = (r >> 4) * 2 + (c >> 5), rr = r & 15, cc = c & 31, ob = rr * 64 + cc * 2; return st * 1024 + (ob ^ (((ob >> 9) & 1) << 5)); }
__host__ __device__ __forceinline__ void stage_rc(int b, int& R, int& C) { const int st = b / 1024, sb = b % 1024, swz = sb ^ (((sb >> 9) & 1) << 5); R = (st >> 1) * 16 + swz / 64; C = (st & 1) * 32 + (swz % 64) / 2; }
__host__ __device__ __forceinline__ int perm32(int rho) { const int n = rho >> 4, i = rho & 15; return 8 * (i >> 2) + 4 * n + (i & 3); }

struct Unit { int pm, pn, ko; };
struct Gemm { const bf16_t* A; const bf16_t* Bt; int M, N, K, ld; };

struct StaticOrder {
    int nM, nN, nwg, G, c;
    __host__ __device__ __forceinline__ void init(int M, int N, int G_, int c_) { nM = M / BM; nN = N / BM; nwg = nM * nN; G = G_; c = c_; }
    __host__ __device__ __forceinline__ bool next(int i, Unit& u) const {
        const long L = (long)i * G + c; if (L >= nwg) return false;
        int wgid = (int)L; { const int q = nwg / NXCD, r = nwg % NXCD, xcd = wgid % NXCD, off = wgid / NXCD; wgid = (xcd < r ? xcd * (q + 1) : r * (q + 1) + (xcd - r) * q) + off; }
        const int nig = WGM * nN, gid = wgid / nig, fm = gid * WGM, gsz = (nM - fm) < WGM ? (nM - fm) : WGM;
        u.pm = fm + ((wgid % nig) % gsz); u.pn = (wgid % nig) / gsz; u.ko = 0; return true;
    }
    __device__ __forceinline__ void a_ready(const Unit&) const {}
    __device__ __forceinline__ void done(const Unit&) const {}
};

}
namespace pg8 {
struct EpiZ {
    static constexpr bool PERM = true, AFTER_DRAIN = false;
    bf16_t* Z; const float* rs; float* out;
    __device__ __forceinline__ void operator()(const f32x4 (&acc)[2][2][4][2], const Unit& u, int wr, int wc, int fr, int fq) const {
        const int row0 = u.pm * BM + wr * 64 + fr;
        const int col0 = u.pn * BM + wc * 32 + 8 * fq;
        const bool isKa = (u.pn >= 4 && u.pn < 8), isKb = (u.pn == 16);
        const bool ctile = (isKa || isKb) && (u.pm >= 128 || (u.pm & 63) >= 62);
#pragma unroll
        for (int ai = 0; ai < 2; ++ai)
#pragma unroll
            for (int m = 0; m < 4; ++m) {
                const int r = row0 + ai * HALF + m * 16;
#pragma unroll
                for (int bj = 0; bj < 2; ++bj) {
                    const f32x4 v0 = acc[ai][bj][m][0], v1 = acc[ai][bj][m][1];
                    u32x4 w; w.x = cvt_pk(v0[0], v0[1]); w.y = cvt_pk(v0[2], v0[3]); w.z = cvt_pk(v1[0], v1[1]); w.w = cvt_pk(v1[2], v1[3]);
                    { const int cc = col0 + bj * HALF; *(u32x4*)(Z + ((size_t)(cc >> 6) * NTOK + r) * 64 + (cc & 63)) = w; }
                    if (ctile) {
                        float* dst = nullptr; const int c = col0 + bj * HALF;
                        if (r >= NTOKP) { const int sidx = r - NTOKP, b = sidx >> 6, i = sidx & 63;
                            dst = isKa ? out + OFF_AKS + ((size_t)(b * 512 + 448 + i) * 1024 + (c - 1024)) : out + OFF_BKS + ((size_t)(b * 128 + 64 + i) * 256 + (c - 4096)); }
                        else { const int b = r >> 14, t = r & 16383;
                            if (isKa) { if (t >= 15872) dst = out + OFF_AKP + ((size_t)(b * 512 + t - 15872) * 1024 + (c - 1024)); }
                            else      { if (t >= 16256) dst = out + OFF_BKP + ((size_t)(b * 128 + t - 16256) * 256 + (c - 4096)); } }
                        if (dst) { *(f32x4*)dst = v0; *(f32x4*)(dst + 4) = v1; }
                    }
                }
            }
    }
};
struct EpiVt {
    static constexpr bool PERM = true, AFTER_DRAIN = false;
    bf16_t* VT; const float* rs; float* out;
    __device__ __forceinline__ void operator()(const f32x4 (&acc)[2][2][4][2], const Unit& u, int wr, int wc, int fr, int fq) const {
        const int row0 = u.pm * BM + wr * 64 + fr;
        const int tok0 = u.pn * BM + wc * 32 + 8 * fq;
        const bool ctile = (u.pn >= 128 || (u.pn & 63) >= 62);
#pragma unroll
        for (int ai = 0; ai < 2; ++ai)
#pragma unroll
            for (int m = 0; m < 4; ++m) {
                const int r = row0 + ai * HALF + m * 16;
#pragma unroll
                for (int bj = 0; bj < 2; ++bj) {
                    const f32x4 v0 = acc[ai][bj][m][0], v1 = acc[ai][bj][m][1];
                    u32x4 w; w.x = cvt_pk(v0[0], v0[1]); w.y = cvt_pk(v0[2], v0[3]); w.z = cvt_pk(v1[0], v1[1]); w.w = cvt_pk(v1[2], v1[3]);
                    { const int tk0 = tok0 + bj * HALF; *(u32x4*)(VT + ((size_t)(tk0 >> 6) * NVC + r) * 64 + (tk0 & 63)) = w; }
                    if (ctile) {
#pragma unroll
                        for (int e = 0; e < 8; ++e) {
                            const int tk = tok0 + bj * HALF + e; const float val = e < 4 ? v0[e & 3] : v1[e & 3];
                            if (tk >= NTOKP) { const int sidx = tk - NTOKP, b = sidx >> 6, i = sidx & 63;
                                if (r < 1024) out[OFF_AVS + (size_t)(b * 512 + 448 + i) * 1024 + r] = val;
                                else          out[OFF_BVS + (size_t)(b * 128 + 64 + i) * 256 + (r - 1024)] = val; }
                            else { const int b = tk >> 14, t = tk & 16383;
                                if (r < 1024) { if (t >= 15872) out[OFF_AVP + (size_t)(b * 512 + t - 15872) * 1024 + r] = val; }
                                else          { if (t >= 16256) out[OFF_BVP + (size_t)(b * 128 + t - 16256) * 256 + (r - 1024)] = val; } }
                        }
                    }
                }
            }
    }
};
struct SplitK8 {
    int G, c;
    __device__ __forceinline__ bool next(int i, Unit& u) const { const int L = i * G + c; if (L >= 128) return false; const int t = L >> 3; u.pm = 128 + (t >> 3); u.pn = t & 7; u.ko = 256 * (L & 7); return true; }
    __device__ __forceinline__ void a_ready(const Unit&) const {}
    __device__ __forceinline__ void done(const Unit&) const {}
};
struct EpiYS {
    static constexpr bool PERM = false, AFTER_DRAIN = false;
    float* YS;
    __device__ __forceinline__ void operator()(const f32x4 (&acc)[2][2][4][2], const Unit& u, int wr, int wc, int fr, int fq) const {
        const int col0 = u.pn * BM + wc * 32 + 4 * fq;
#pragma unroll
        for (int ai = 0; ai < 2; ++ai)
#pragma unroll
            for (int m = 0; m < 4; ++m) {
                float* yrow = YS + ((size_t)(u.ko >> 8) * 512 + (u.pm - 128) * BM + ai * HALF + wr * 64 + m * 16 + fr) * DM + col0;
#pragma unroll
                for (int bj = 0; bj < 2; ++bj)
#pragma unroll
                    for (int n = 0; n < 2; ++n) *(f32x4*)(yrow + bj * HALF + n * 16) = acc[ai][bj][m][n];
            }
    }
};
struct EpiY {
    static constexpr bool PERM = true, AFTER_DRAIN = false;
    const float* xp; const float* xs; bf16_t* YB; float* pss;
    __device__ __forceinline__ const float* xrow(int r) const { return (r < NTOKP) ? xp + (size_t)r * DM : xs + (size_t)(r - NTOKP) * DM; }
    __device__ __forceinline__ void operator()(const f32x4 (&acc)[2][2][4][2], const Unit& u, int wr, int wc, int fr, int fq) const {
        const int col0 = u.pn * BM + wc * 32 + 8 * fq;
        const int rbase = u.pm * BM + wr * 64 + fr;
        f32x4 xv[2][2];
        { const float* xr = xrow(rbase) + col0; xv[0][0] = __builtin_nontemporal_load((const f32x4*)(xr)); xv[0][1] = __builtin_nontemporal_load((const f32x4*)(xr + 4)); }
        float q = 0.f;
#pragma unroll
        for (int s2 = 0; s2 < 16; ++s2) {
            const int g = s2 >> 1, bj = s2 & 1, ai = g >> 2, m = g & 3, cb = s2 & 1;
            if (s2 + 1 < 16) { const int g1 = (s2 + 1) >> 1, bj1 = (s2 + 1) & 1; const int r1 = rbase + (g1 >> 2) * HALF + (g1 & 3) * 16; const float* xr = xrow(r1) + col0 + bj1 * HALF;
                xv[cb ^ 1][0] = __builtin_nontemporal_load((const f32x4*)(xr)); xv[cb ^ 1][1] = __builtin_nontemporal_load((const f32x4*)(xr + 4)); }
            const int r = rbase + ai * HALF + m * 16;
            const f32x4 y0 = xv[cb][0] + acc[ai][bj][m][0], y1 = xv[cb][1] + acc[ai][bj][m][1];
            u32x4 w; w.x = cvt_pk(y0[0], y0[1]); w.y = cvt_pk(y0[2], y0[3]); w.z = cvt_pk(y1[0], y1[1]); w.w = cvt_pk(y1[2], y1[3]);
            *(u32x4*)(YB + (size_t)r * DM + col0 + bj * HALF) = w;
            q += (y0[0] * y0[0] + y0[1] * y0[1]) + (y0[2] * y0[2] + y0[3] * y0[3]) + (y1[0] * y1[0] + y1[1] * y1[1]) + (y1[2] * y1[2] + y1[3] * y1[3]);
            if (bj == 1) { q += __shfl_xor(q, 16); q += __shfl_xor(q, 32); if (fq == 0) pss[(size_t)r * 32 + u.pn * 4 + wc] = q; q = 0.f; }
        }
    }
};
}

namespace pg8 {
template <class Epi, class Sched, bool ALIGN_EPI = false, bool SP2 = false>
__device__ __forceinline__ void gemm_phase(PG8_LAS unsigned char* lds, const Gemm g, const Sched& S, const Epi& E) {
    int tid_ = threadIdx.x; asm volatile("" : "+v"(tid_)); const int tid = tid_, wid = __builtin_amdgcn_readfirstlane(tid >> 6), lane = tid & 63, wr = wid >> 2, wc = wid & 3, fr = lane & 15, fq = lane >> 4;
    const int K = g.K, nt = K / BK, LD = g.ld;
    unsigned voffA[2], voffB[2];
#pragma unroll
    for (int i = 0; i < 2; ++i) { int R, C; stage_rc(tid * 16 + i * 8192, R, C); const int Rb = Epi::PERM ? ((R & ~31) + perm32(R & 31)) : R;
        voffA[i] = (unsigned)(R * LD + C) * 2u; voffB[i] = (unsigned)(Rb * LD + C) * 2u; }
    const size_t kstep = (size_t)(BK * 2);
    const size_t hstep = (size_t)HALF * LD * 2;
    const size_t tstep = 2 * hstep;
    const unsigned ldsw = (unsigned)wid * 1024u;
    const int aoff = lds_byte(wr * 64 + fr, fq * 8), boff = lds_byte(wc * 32 + fr, fq * 8);
#define PG8_SA(b, h) (((b) * 2 + (h)) * HTB)
#define PG8_SB(b, h) ((4 + (b) * 2 + (h)) * HTB)
#define PG8_STAGE(bufoff, gbase, voff) do { _Pragma("unroll") for (int _i = 0; _i < 2; ++_i) \
        __builtin_amdgcn_global_load_lds((const unsigned*)((const char*)(gbase) + (voff)[_i]), (PG8_LAS unsigned*)(lds + (bufoff) + ldsw + _i * 8192), 16, 0, 0); } while (0)
#define PG8_LDA(dst, b, h) do { _Pragma("unroll") for (int m = 0; m < 4; ++m) _Pragma("unroll") for (int k = 0; k < 2; ++k) dst[m][k] = *(const PG8_LAS bf16x8*)(lds + PG8_SA(b, h) + aoff + m * 2048 + k * 1024); } while (0)
#define PG8_LDB(dst, b, h) do { _Pragma("unroll") for (int n = 0; n < 2; ++n) _Pragma("unroll") for (int k = 0; k < 2; ++k) dst[n][k] = *(const PG8_LAS bf16x8*)(lds + PG8_SB(b, h) + boff + n * 2048 + k * 1024); } while (0)
#define PG8_MMA(ai, bj, At, Bt) do { __builtin_amdgcn_s_setprio(1); _Pragma("unroll") for (int m = 0; m < 4; ++m) _Pragma("unroll") for (int n = 0; n < 2; ++n) _Pragma("unroll") for (int k = 0; k < 2; ++k) \
        acc[ai][bj][m][n] = __builtin_amdgcn_mfma_f32_16x16x32_bf16(Bt[n][k], At[m][k], acc[ai][bj][m][n], 0, 0, 0); __builtin_amdgcn_s_setprio(0); } while (0)
#define PG8_WAIT_V(n) asm volatile("s_waitcnt vmcnt(" #n ")" ::: "memory")
#define PG8_WAIT_L(n) asm volatile("s_waitcnt lgkmcnt(" #n ")" ::: "memory")
#define PG8_BAR __builtin_amdgcn_s_barrier()
#define PG8_SCHED __builtin_amdgcn_sched_barrier(0)
    Unit cur, nxt; int ui = 0;
    if (!S.next(0, cur)) return;
    f32x4 acc[2][2][4][2];
#pragma unroll
    for (int a = 0; a < 2; ++a)
#pragma unroll
        for (int b = 0; b < 2; ++b)
#pragma unroll
            for (int m = 0; m < 4; ++m)
#pragma unroll
                for (int n = 0; n < 2; ++n) acc[a][b][m][n] = (f32x4){0.f, 0.f, 0.f, 0.f};
    bf16x8 At[4][2], B0[2][2], B1[2][2];
    const char* cA = (const char*)g.A + (size_t)cur.pm * tstep + (size_t)cur.ko * 2; const char* cB = (const char*)g.Bt + (size_t)cur.pn * tstep + (size_t)cur.ko * 2;
    S.a_ready(cur);
    if constexpr (SP2) {
        PG8_STAGE(PG8_SB(0, 0), cB, voffB); PG8_STAGE(PG8_SB(0, 1), cB + hstep, voffB); PG8_STAGE(PG8_SA(0, 0), cA, voffA); PG8_STAGE(PG8_SA(0, 1), cA + hstep, voffA);
        if (wr == 1) PG8_BAR;
        PG8_WAIT_V(2); PG8_BAR;
        PG8_STAGE(PG8_SB(1, 0), cB + kstep, voffB); PG8_STAGE(PG8_SA(1, 0), cA + kstep, voffA); PG8_STAGE(PG8_SB(1, 1), cB + hstep + kstep, voffB);
        PG8_WAIT_V(6); PG8_BAR;
    } else {
        PG8_STAGE(PG8_SB(0, 0), cB, voffB); PG8_STAGE(PG8_SA(0, 0), cA, voffA); PG8_STAGE(PG8_SB(0, 1), cB + hstep, voffB); PG8_STAGE(PG8_SA(0, 1), cA + hstep, voffA);
        if (wr == 1) PG8_BAR;
        PG8_WAIT_V(4); PG8_BAR;
        PG8_STAGE(PG8_SB(1, 0), cB + kstep, voffB); PG8_STAGE(PG8_SA(1, 0), cA + kstep, voffA); PG8_STAGE(PG8_SB(1, 1), cB + hstep + kstep, voffB);
        PG8_WAIT_V(6); PG8_BAR;
    }
    for (;;) {
        const bool has_next = S.next(ui + 1, nxt);
        const char* nA = has_next ? (const char*)g.A + (size_t)nxt.pm * tstep + (size_t)nxt.ko * 2 : cA; const char* nB = has_next ? (const char*)g.Bt + (size_t)nxt.pn * tstep + (size_t)nxt.ko * 2 : cB;
        for (int t = 0; t < nt; t += 2) {
            const bool last = (t == nt - 2);
            const char* a1 = cA + (size_t)(t + 1) * kstep;
            const char* a2 = last ? nA : cA + (size_t)(t + 2) * kstep; const char* b2 = last ? nB : cB + (size_t)(t + 2) * kstep;
            const char* a3 = a2 + kstep; const char* b3 = b2 + kstep;
            if (last && has_next) S.a_ready(nxt);
            if constexpr (SP2) {
            PG8_LDB(B0, 0, 0); PG8_LDB(B1, 0, 1); PG8_SCHED; PG8_LDA(At, 0, 0); PG8_STAGE(PG8_SA(1, 1), a1 + hstep, voffA);
            PG8_WAIT_V(8); PG8_WAIT_L(0); PG8_BAR; PG8_MMA(0, 0, At, B0); PG8_MMA(0, 1, At, B1); PG8_BAR; PG8_SCHED;
            PG8_LDA(At, 0, 1); PG8_STAGE(PG8_SB(0, 0), b2, voffB); PG8_STAGE(PG8_SB(0, 1), b2 + hstep, voffB); PG8_STAGE(PG8_SA(0, 0), a2, voffA);
            PG8_WAIT_V(8); PG8_WAIT_L(0); PG8_BAR; PG8_MMA(1, 0, At, B0); PG8_MMA(1, 1, At, B1); PG8_BAR; PG8_SCHED;
            PG8_LDB(B0, 1, 0); PG8_LDB(B1, 1, 1); PG8_SCHED; PG8_LDA(At, 1, 0); PG8_STAGE(PG8_SA(0, 1), a2 + hstep, voffA);
            PG8_WAIT_V(8); PG8_WAIT_L(0); PG8_BAR; PG8_MMA(0, 0, At, B0); PG8_MMA(0, 1, At, B1); PG8_BAR; PG8_SCHED;
            PG8_LDA(At, 1, 1); PG8_STAGE(PG8_SB(1, 0), b3, voffB); PG8_STAGE(PG8_SB(1, 1), b3 + hstep, voffB); PG8_STAGE(PG8_SA(1, 0), a3, voffA);
            PG8_WAIT_V(8); PG8_WAIT_L(0); PG8_BAR; PG8_MMA(1, 0, At, B0); PG8_MMA(1, 1, At, B1); PG8_BAR; PG8_SCHED;
            } else {
            PG8_LDB(B0, 0, 0); PG8_SCHED; PG8_LDA(At, 0, 0); PG8_STAGE(PG8_SA(1, 1), a1 + hstep, voffA);
            PG8_WAIT_L(8); PG8_BAR; PG8_WAIT_L(0); PG8_MMA(0, 0, At, B0); PG8_BAR; PG8_SCHED;
            PG8_LDB(B1, 0, 1); PG8_STAGE(PG8_SB(0, 0), b2, voffB);
            PG8_BAR; PG8_WAIT_L(0); PG8_MMA(0, 1, At, B1); PG8_BAR;
            PG8_LDA(At, 0, 1); PG8_STAGE(PG8_SA(0, 0), a2, voffA);
            PG8_BAR; PG8_WAIT_L(0); PG8_MMA(1, 0, At, B0); PG8_BAR; PG8_SCHED;
            PG8_STAGE(PG8_SB(0, 1), b2 + hstep, voffB);
            PG8_WAIT_V(6); PG8_BAR; PG8_MMA(1, 1, At, B1); PG8_BAR;
            PG8_LDB(B0, 1, 0); PG8_SCHED; PG8_LDA(At, 1, 0); PG8_STAGE(PG8_SA(0, 1), a2 + hstep, voffA);
            PG8_WAIT_L(8); PG8_BAR; PG8_WAIT_L(0); PG8_MMA(0, 0, At, B0); PG8_BAR; PG8_SCHED;
            PG8_LDB(B1, 1, 1); PG8_STAGE(PG8_SB(1, 0), b3, voffB);
            PG8_BAR; PG8_WAIT_L(0); PG8_MMA(0, 1, At, B1); PG8_BAR;
            PG8_LDA(At, 1, 1); PG8_STAGE(PG8_SA(1, 0), a3, voffA);
            PG8_BAR; PG8_WAIT_L(0); PG8_MMA(1, 0, At, B0); PG8_BAR; PG8_SCHED;
            PG8_STAGE(PG8_SB(1, 1), b3 + hstep, voffB);
            PG8_WAIT_V(6); PG8_BAR; PG8_MMA(1, 1, At, B1); PG8_BAR;
            }
        }
        if constexpr (ALIGN_EPI) { if (wr == 0) PG8_BAR; }
        if constexpr (!Epi::AFTER_DRAIN) { E(acc, cur, wr, wc, fr, fq); S.done(cur); }
        if (!has_next) break;
#pragma unroll
        for (int a = 0; a < 2; ++a)
#pragma unroll
            for (int b = 0; b < 2; ++b)
#pragma unroll
                for (int m = 0; m < 4; ++m)
#pragma unroll
                    for (int n = 0; n < 2; ++n) acc[a][b][m][n] = (f32x4){0.f, 0.f, 0.f, 0.f};
        cur = nxt; cA = nA; cB = nB; ++ui;
        if constexpr (ALIGN_EPI) { if (wr == 1) PG8_BAR; }
    }
    PG8_WAIT_V(0);
    if constexpr (!ALIGN_EPI) { if (wr == 0) PG8_BAR; }
    PG8_BAR;
    if constexpr (Epi::AFTER_DRAIN) { E.fused(acc, cur, wr, wc, fr, fq, lds, wid, lane); S.done(cur); }
#undef PG8_SA
#undef PG8_SB
#undef PG8_STAGE
#undef PG8_LDA
#undef PG8_LDB
#undef PG8_MMA
#undef PG8_WAIT_V
#undef PG8_WAIT_L
#undef PG8_BAR
#undef PG8_SCHED
}
}
__device__ __forceinline__ void transpose_item(const float* __restrict__ W, int N, bf16_t* __restrict__ WT, int ldt, LAS float* scr, int k0, int n0, int dest_row0,
                                               const float* __restrict__ gain, float mul, int lane) {
    f32x4 v[8];
#pragma unroll
    for (int i = 0; i < 8; ++i) { const int pp = lane + 64 * i, kk = pp >> 3, c4 = pp & 7; v[i] = __builtin_nontemporal_load((const f32x4*)(W + (size_t)(k0 + kk) * N + n0 + 4 * c4)); }
#pragma unroll
    for (int i = 0; i < 8; ++i) { const int pp = lane + 64 * i, kk = pp >> 3, c4 = pp & 7; const float g = gain ? gain[k0 + kk] * mul : mul;
        LAS float* d = scr + kk * 33 + 4 * c4; d[0] = v[i][0] * g; d[1] = v[i][1] * g; d[2] = v[i][2] * g; d[3] = v[i][3] * g; }
    LDS_WAIT(); asm volatile("" ::: "memory");
    const int c = lane & 7;
#pragma unroll
    for (int j = 0; j < 4; ++j) { const int n = (lane >> 3) + 8 * j; const LAS float* s = scr + (8 * c) * 33 + n;
        u32x4 o; o.x = cvt_pk(s[0 * 33], s[1 * 33]); o.y = cvt_pk(s[2 * 33], s[3 * 33]); o.z = cvt_pk(s[4 * 33], s[5 * 33]); o.w = cvt_pk(s[6 * 33], s[7 * 33]);
        *(u32x4*)(WT + (size_t)(dest_row0 + n) * ldt + k0 + 8 * c) = o; }
    LDS_WAIT(); asm volatile("" ::: "memory");
}
__device__ __forceinline__ int permcol(int n) {
    if (n < 2048) return n;
    if (n < 3072) return 5376 + (n - 2048);
    if (n < 4096) return 2048 + (n - 3072);
    if (n < 5120) return 3072 + (n - 4096);
    if (n < 5376) return 4096 + (n - 5120);
    if (n < 5632) return 6400 + (n - 5376);
    return 4352 + (n - 5632);
}
__device__ __forceinline__ void cache_copy(const float* __restrict__ src, float* __restrict__ dstf, bf16_t* __restrict__ dstb, int rows, int rowlen, int gtid, int gthreads) {
    const int per_b = rows * rowlen, n4 = 8 * per_b / 4;
    for (int i4 = gtid; i4 < n4; i4 += gthreads) {
        const int e = i4 * 4, b = e / per_b, rem = e - b * per_b, r = rem / rowlen;
        const f32x4 v = __builtin_nontemporal_load((const f32x4*)(src + e));
        if (dstb) { u32x2 w; w.x = cvt_pk(v[0], v[1]); w.y = cvt_pk(v[2], v[3]); *(u32x2*)(dstb + e) = w; }
        if (r >= 64) __builtin_nontemporal_store(v, (f32x4*)(dstf + (size_t)b * per_b + rem - 64 * rowlen));
    }
}
__device__ __forceinline__ void phase0(const Params& p, LAS unsigned char* lds) {
    int tid_ = threadIdx.x; asm volatile("" : "+v"(tid_));
    const int tid = tid_, lane = tid & 63, wave = __builtin_amdgcn_readfirstlane(tid >> 6);
    LAS float* scr = (LAS float*)(lds + wave * 16384);
    const int gw = blockIdx.x * 8 + wave, NGW = gridDim.x * 8;
    unsigned char* ws = p.ws;
    bf16_t* W1T = (bf16_t*)(ws + WS_W1T); bf16_t* W2T = (bf16_t*)(ws + WS_W2T);
    constexpr int I_W1 = 32 * 208, I_W2 = 32 * 64;
    if (wave < 2) for (int it = blockIdx.x * 2 + wave; it < I_W1 + I_W2; it += gridDim.x * 2) {
        int r = it;
        if (r < I_W1) { const int kb = r / 208, nb = r % 208, n0 = nb * 32; const bool isq = (n0 < 1024) || (n0 >= 4096 && n0 < 5120);
            transpose_item(p.in[7], 6656, W1T, 2048, scr, kb * 64, n0, permcol(n0), p.in[6], isq ? C2 : 1.0f, lane); continue; }
        r -= I_W1;
        { const int kb = r / 64, nb = r % 64; transpose_item(p.in[10], 2048, W2T, 2048, scr, kb * 64, nb * 32, nb * 32, nullptr, 1.0f, lane); }
    }
    bf16_t* XB = (bf16_t*)(ws + WS_XB);
    if (wave >= 2) for (int m = blockIdx.x * 6 + (wave - 2); m < NTOK; m += gridDim.x * 6) {
        const float* xrow = (m < NTOKP) ? p.in[0] + (size_t)m * DM : p.in[1] + (size_t)(m - NTOKP) * DM;
        const f32x4* xr = (const f32x4*)xrow + lane;
        f32x4 v[8]; float s = 0.f;
#pragma unroll
        for (int j = 0; j < 8; ++j) { v[j] = __builtin_nontemporal_load(&xr[64 * j]); s += (v[j][0] * v[j][0] + v[j][1] * v[j][1]) + (v[j][2] * v[j][2] + v[j][3] * v[j][3]); }
        s = wave_sum(s);
        const float rr = 1.0f / sqrtf(s * (1.0f / DM) + RMS_EPS);
        u32x2* o8 = (u32x2*)(XB + (size_t)m * DM) + lane;
#pragma unroll
        for (int j = 0; j < 8; ++j) { u32x2 w; w.x = cvt_pk(v[j][0] * rr, v[j][1] * rr); w.y = cvt_pk(v[j][2] * rr, v[j][3] * rr); o8[64 * j] = w; }
    }
    const int gtid = blockIdx.x * 512 + tid, gthreads = gridDim.x * 512;
    for (int i = gtid; i < 16 * 320; i += gthreads) ((float*)(ws + WS_TAB))[i] = p.in[8][i] * LOG2E;
    if (gtid < 16) ((float*)(ws + WS_SINK))[gtid] = p.in[9][gtid] * LOG2E;
    for (int i = gtid; i < DM; i += gthreads) ((float*)(ws + WS_GF))[i] = p.in[11][i];
    for (int i = gtid; i < 512 * DM / 4; i += gthreads) ((f32x4*)(ws + WS_XS))[i] = ((const f32x4*)p.in[1])[i];
}

__device__ __forceinline__ void cache_phase(LAS unsigned char* lds, int w, int nw) {
    int tid_ = threadIdx.x; asm volatile("" : "+v"(tid_));
    const int tid = tid_, lane = tid & 63, wave = __builtin_amdgcn_readfirstlane(tid >> 6);
    kparams_t kp = fresh_params(); unsigned char* ws = kp->ws; float* out = kp->out;
    const float* cak = kp->in[2]; const float* cav = kp->in[3]; const float* cbk = kp->in[4]; const float* cbv = kp->in[5];
    LAS float* scr = (LAS float*)(lds + wave * 16384);
    constexpr int I_CAV = 8 * 8 * 32, I_CBV = 8 * 2 * 8;
    for (int r = w * 8 + wave; r < I_CAV + I_CBV; r += nw * 8) {
        if (r < I_CAV) { const int b = r >> 8, q = r & 255, kb = q >> 5, nb = q & 31;
            transpose_item(cav + (size_t)b * 512 * 1024, 1024, (bf16_t*)(ws + WS_CAVT) + (size_t)b * 1024 * 512, 512, scr, kb * 64, nb * 32, nb * 32, nullptr, 1.0f, lane); }
        else { const int r2 = r - I_CAV, b = r2 >> 4, q = r2 & 15, kb = q >> 3, nb = q & 7;
            transpose_item(cbv + (size_t)b * 128 * 256, 256, (bf16_t*)(ws + WS_CBVT) + (size_t)b * 256 * 128, 128, scr, kb * 64, nb * 32, nb * 32, nullptr, 1.0f, lane); }
    }
    const int gtid = w * 512 + tid, gthreads = nw * 512;
    cache_copy(cak, out + OFF_AKS, (bf16_t*)(ws + WS_CAK), 512, 1024, gtid, gthreads);
    cache_copy(cav, out + OFF_AVS, nullptr, 512, 1024, gtid, gthreads);
    cache_copy(cbk, out + OFF_BKS, (bf16_t*)(ws + WS_CBK), 128, 256, gtid, gthreads);
    cache_copy(cbv, out + OFF_BVS, nullptr, 128, 256, gtid, gthreads);
}

#define MFMA32(a, b, c) __builtin_amdgcn_mfma_f32_32x32x16_bf16((a), (b), (c), 0, 0, 0)
__device__ __forceinline__ float ex2(float x) { return __builtin_amdgcn_exp2f(x); }
constexpr int AT_BUFB = 70656, AT_VROW = 144, AT_TAB = 2 * AT_BUFB;

template <int HG>
__device__ __forceinline__ void at_load(u32x4 (&kr)[HG], u32x4 (&vr)[HG], const bf16_t* __restrict__ Kb, int kstr, size_t khs, const bf16_t* __restrict__ Vb, int vstr, int tid) {
#pragma unroll
    for (int i = 0; i < HG; ++i) { const int pp = tid + 512 * i; const int row = pp / (HG * 8), c16 = pp % (HG * 8);
        kr[i] = *(const u32x4*)(Kb + (size_t)(c16 >> 3) * khs + (size_t)row * kstr + (c16 & 7) * 8); }
#pragma unroll
    for (int i = 0; i < HG; ++i) { const int pp = tid + 512 * i; const int row = pp >> 3, c16 = pp & 7;
        vr[i] = *(const u32x4*)(Vb + (size_t)row * vstr + c16 * 8); }
}
template <int HG>
__device__ __forceinline__ void at_store(const u32x4 (&kr)[HG], const u32x4 (&vr)[HG], LAS unsigned char* buf, int tid) {
    constexpr int RS = HG * 128 + 16, KB = 64 * RS;
#pragma unroll
    for (int i = 0; i < HG; ++i) { const int pp = tid + 512 * i; const int row = pp / (HG * 8), c16 = pp % (HG * 8);
        *(LAS u32x4*)(buf + row * RS + c16 * 16) = kr[i]; }
#pragma unroll
    for (int i = 0; i < HG; ++i) { const int pp = tid + 512 * i; const int row = pp >> 3, c16 = pp & 7;
        LAS unsigned char* d = buf + KB + row * AT_VROW + ((c16 & ~1) * 2 + (c16 & 1)) * 8;
        *(LAS u32x2*)(d) = (u32x2){vr[i].x, vr[i].y}; *(LAS u32x2*)(d + 16) = (u32x2){vr[i].z, vr[i].w}; }
}

constexpr int PR_BUFB = 9216 + 64 * AT_VROW, PR_PAIRB = 2 * PR_BUFB, PR_TAB = 4 * PR_PAIRB;
__device__ __forceinline__ void at_load_p(u32x4 (&kr)[4], u32x4 (&vr)[4], const bf16_t* __restrict__ Kb, int kstr, const bf16_t* __restrict__ Vb, int vstr, int ptid) {
#pragma unroll
    for (int i = 0; i < 4; ++i) { const int pp = ptid + 128 * i, row = pp >> 3, c16 = pp & 7; kr[i] = *(const u32x4*)(Kb + (size_t)row * kstr + c16 * 8); }
#pragma unroll
    for (int i = 0; i < 4; ++i) { const int pp = ptid + 128 * i, row = pp >> 3, c16 = pp & 7; vr[i] = *(const u32x4*)(Vb + (size_t)row * vstr + c16 * 8); }
}
__device__ __forceinline__ void at_store_p(const u32x4 (&kr)[4], const u32x4 (&vr)[4], LAS unsigned char* buf, int ptid) {
#pragma unroll
    for (int i = 0; i < 4; ++i) { const int pp = ptid + 128 * i, row = pp >> 3, c16 = pp & 7; *(LAS u32x4*)(buf + row * 144 + c16 * 16) = kr[i]; }
#pragma unroll
    for (int i = 0; i < 4; ++i) { const int pp = ptid + 128 * i, row = pp >> 3, c16 = pp & 7;
        LAS unsigned char* d = buf + 9216 + row * AT_VROW + ((c16 & ~1) * 2 + (c16 & 1)) * 8;
        *(LAS u32x2*)(d) = (u32x2){vr[i].x, vr[i].y}; *(LAS u32x2*)(d + 16) = (u32x2){vr[i].z, vr[i].w}; }
}
__device__ __forceinline__ void pair_sync(volatile LAS unsigned* cnt, unsigned& ep, int lane) {
    asm volatile("s_waitcnt lgkmcnt(0)" ::: "memory");
    ep += 2u;
    if (lane == 0) __hip_atomic_fetch_add((LAS unsigned*)cnt, 1u, __ATOMIC_RELAXED, __HIP_MEMORY_SCOPE_WORKGROUP);
    while (*cnt < ep) __builtin_amdgcn_s_sleep(1);
    asm volatile("" ::: "memory");
}

template <bool ISA, int HG>
__device__ __forceinline__ void attn_tile(const LAS unsigned char* buf, int hl, const bf16x8 (&q)[4], f32x16& o0, f32x16& o1, float& m, float& l,
                                          int bias_base, bool cbias, float cval, float slope2, const LAS float* tab, int r32, int hi) {
    constexpr int RS = HG * 128 + 16, KB = 64 * RS;
    const LAS unsigned char* kp = buf + r32 * RS + (hl * 64 + 8 * hi) * 2;
    bf16x8 k0[4], k1[4];
#pragma unroll
    for (int d0 = 0; d0 < 4; ++d0) { k0[d0] = *(const LAS bf16x8*)(kp + 32 * d0); k1[d0] = *(const LAS bf16x8*)(kp + 32 * RS + 32 * d0); }
    f32x16 s0, s1;
    if (ISA) {
        if (cbias) {
#pragma unroll
            for (int r = 0; r < 16; ++r) { s0[r] = 0.f; s1[r] = 0.f; }
        } else {
            const LAS float* tb = tab + (383 - bias_base);
#pragma unroll
            for (int r = 0; r < 16; ++r) { const int off = (r & 3) + 8 * (r >> 2); s0[r] = tb[off]; s1[r] = tb[off + 32]; }
        }
    } else {
#pragma unroll
        for (int r = 0; r < 16; ++r) { const int off = (r & 3) + 8 * (r >> 2); const int d = bias_base - off;
            s0[r] = -slope2 * fabsf((float)d); s1[r] = -slope2 * fabsf((float)(d - 32)); }
    }
#pragma unroll
    for (int d0 = 0; d0 < 4; ++d0) { s0 = MFMA32(k0[d0], q[d0], s0); s1 = MFMA32(k1[d0], q[d0], s1); }
    float mx;
    { float m4[4];
#pragma unroll
      for (int k = 0; k < 4; ++k) { m4[k] = fmaxf(fmaxf(s0[k], s1[k]), s0[k + 4]); m4[k] = fmaxf(fmaxf(m4[k], s1[k + 4]), s0[k + 8]); m4[k] = fmaxf(fmaxf(m4[k], s1[k + 8]), s0[k + 12]); m4[k] = fmaxf(m4[k], s1[k + 12]); }
      mx = fmaxf(fmaxf(m4[0], m4[1]), fmaxf(m4[2], m4[3])); }
    { auto rr = __builtin_amdgcn_permlane32_swap(__float_as_uint(mx), __float_as_uint(mx), false, false); mx = fmaxf(__uint_as_float(rr[0]), __uint_as_float(rr[1])); }
    const float csh = (ISA && cbias) ? cval : 0.f;
    mx += csh;
    if (__builtin_amdgcn_ballot_w64(mx > m + 8.0f) != 0ull) {
        const float mn = fmaxf(m, mx), alpha = ex2(m - mn); m = mn; l *= alpha;
#pragma unroll
        for (int r = 0; r < 16; ++r) { o0[r] *= alpha; o1[r] *= alpha; }
    }
    { const float mr = m - csh;
#pragma unroll
      for (int r = 0; r < 16; ++r) { s0[r] = ex2(s0[r] - mr); s1[r] = ex2(s1[r] - mr); } }
    { float a4[4];
#pragma unroll
      for (int k = 0; k < 4; ++k) {
          float t0 = s0[k] + s1[k], t1 = s0[k + 4] + s1[k + 4], t2 = s0[k + 8] + s1[k + 8], t3 = s0[k + 12] + s1[k + 12];
          asm volatile("" : "+v"(t0), "+v"(t1), "+v"(t2), "+v"(t3));
          float u0 = t0 + t1, u1 = t2 + t3; asm volatile("" : "+v"(u0), "+v"(u1));
          a4[k] = u0 + u1; asm volatile("" : "+v"(a4[k])); }
      float w0 = a4[0] + a4[1], w1 = a4[2] + a4[3]; asm volatile("" : "+v"(w0), "+v"(w1));
      l += w0 + w1; }
    bf16x8 pf[4];
#pragma unroll
    for (int ks = 0; ks < 4; ++ks) { u32x4 w;
        if (ks < 2) { const int b = 8 * ks; w.x = cvt_pk(s0[b], s0[b + 1]); w.y = cvt_pk(s0[b + 2], s0[b + 3]); w.z = cvt_pk(s0[b + 4], s0[b + 5]); w.w = cvt_pk(s0[b + 6], s0[b + 7]); }
        else { const int b = 8 * (ks - 2); w.x = cvt_pk(s1[b], s1[b + 1]); w.y = cvt_pk(s1[b + 2], s1[b + 3]); w.z = cvt_pk(s1[b + 4], s1[b + 5]); w.w = cvt_pk(s1[b + 6], s1[b + 7]); }
        pf[ks] = __builtin_bit_cast(bf16x8, w); }
    __builtin_amdgcn_sched_barrier(0);
    const LAS unsigned char* vp0 = buf + KB + (hl * 64 + r32) * AT_VROW + 16 * hi;
    const LAS unsigned char* vp1 = vp0 + 32 * AT_VROW;
    u32x4 va[2][4];
#pragma unroll
    for (int ks = 0; ks < 4; ++ks) { va[0][ks] = *(const LAS u32x4*)(vp0 + 32 * ks); va[1][ks] = *(const LAS u32x4*)(vp1 + 32 * ks); }
    __builtin_amdgcn_sched_barrier(0);
#pragma unroll
    for (int ks = 0; ks < 4; ++ks) {
        o0 = MFMA32(__builtin_bit_cast(bf16x8, va[0][ks]), pf[ks], o0); o1 = MFMA32(__builtin_bit_cast(bf16x8, va[1][ks]), pf[ks], o1); }
}

template <bool ISA, bool PAIR>
__device__ __forceinline__ void attn_stream(unsigned char* ws, int vb, LAS unsigned char* lds, int tid, int lane, int wave) {
    static_assert(ISA || !PAIR, "pair mode is for type A");
    constexpr int HG = PAIR ? 1 : (ISA ? 4 : 1), NP = ISA ? 8 : 2, NKR = PAIR ? 4 : HG;
    const int ptid = tid & 127, pr = wave >> 1;
    LAS unsigned char* const pbase = PAIR ? lds + pr * PR_PAIRB : lds;
    constexpr int BUFB = PAIR ? PR_BUFB : AT_BUFB;
    volatile LAS unsigned* const pcnt = (volatile LAS unsigned*)(lds + MISC_OFF + 16) + pr; unsigned ep = 0u;
    if (PAIR) { __syncthreads(); if (lane == 0 && (wave & 1) == 0) *pcnt = 0u; __syncthreads(); }
#define AT_LOAD(Kb, kstr, khs, Vb, vstr) do { if constexpr (PAIR) at_load_p(kr, vr, Kb, kstr, Vb, vstr, ptid); else at_load<HG>(kr, vr, Kb, kstr, khs, Vb, vstr, tid); } while (0)
#define AT_STORE(buf) do { if constexpr (PAIR) at_store_p(kr, vr, buf, ptid); else at_store<HG>(kr, vr, buf, tid); } while (0)
#define AT_SYNC() do { if constexpr (PAIR) pair_sync(pcnt, ep, lane); else __syncthreads(); } while (0)
    const int r32 = lane & 31, hi = lane >> 5;
    const bf16_t* Z = (const bf16_t*)(ws + WS_Z); const bf16_t* VT = (const bf16_t*)(ws + WS_VT); bf16_t* O = (bf16_t*)(ws + WS_O);
    const int gidx = vb & 3, ubase = 32 * ((vb >> 2) & 1) + (vb >> 3);
    const int hl = (ISA && !PAIR) ? (wave >> 1) : 0, h = gidx * 4 + (wave >> 1), qblk = wave & 1;
    const int i = qblk * 32 + r32;
    const int qcol = ISA ? h * 64 : 3072 + h * 64, gcol = ISA ? 2048 + h * 64 : 4352 + h * 64, ocol = ISA ? h * 64 : 1024 + h * 64;
    const int hoff = PAIR ? pr * 64 : 0;
    const int kcol = (ISA ? 1024 + gidx * 256 : 4096 + gidx * 64) + hoff, vrow = (ISA ? gidx * 256 : 1024 + gidx * 64) + hoff;
    LAS float* tab = (LAS float*)(lds + (PAIR ? PR_TAB : AT_TAB)) + wave * 384;
    u32x4 kr[NKR], vr[NKR];
#define AT_J0(uu) (((uu) >= 512) ? 0 : ((((uu) & 255) < NP) ? NP - ((uu) & 255) : 0))
#define AT_SRC(uu, j, Kb, kstr, Vb, vstr) \
    const bf16_t* Kb; int kstr; size_t khs; const bf16_t* Vb; int vstr; \
    if ((uu) >= 512 && (j) < NP) { const int b_ = (uu) - 512; \
        if (ISA) { Kb = (const bf16_t*)(ws + WS_CAK) + ((size_t)(b_ * 512 + (j) * 64) * 1024 + gidx * 256 + hoff); kstr = 1024; khs = 64; \
                   Vb = (const bf16_t*)(ws + WS_CAVT) + ((size_t)(b_ * 1024 + gidx * 256 + hoff) * 512 + (j) * 64); vstr = 512; } \
        else     { Kb = (const bf16_t*)(ws + WS_CBK) + ((size_t)(b_ * 128 + (j) * 64) * 256 + gidx * 64); kstr = 256; khs = 64; \
                   Vb = (const bf16_t*)(ws + WS_CBVT) + ((size_t)(b_ * 256 + gidx * 64) * 128 + (j) * 64); vstr = 128; } \
    } else { const size_t R = (size_t)((uu) - NP + (j)) * 64; Kb = Z + ((size_t)(kcol >> 6) * NTOK + R) * 64; kstr = 64; khs = ZHS; Vb = VT + ((size_t)((uu) - NP + (j)) * NVC + vrow) * 64; vstr = 64; }
    { const int jf = AT_J0(ubase); AT_SRC(ubase, jf, Kb, kstr, Vb, vstr); AT_LOAD(Kb, kstr, khs, Vb, vstr); }
    bf16x8 q[4];
    { const bf16_t* qp = Z + ((size_t)(qcol >> 6) * NTOK + (size_t)ubase * 64 + i) * 64 + 8 * hi;
#pragma unroll
      for (int d0 = 0; d0 < 4; ++d0) q[d0] = __builtin_nontemporal_load((const bf16x8*)(qp + 16 * d0)); }
    float slope2 = 0.f, cval = 0.f, sink2 = 0.f;
    if (ISA) { const float* rb = (const float*)(ws + WS_TAB) + h * 320;
#pragma unroll
        for (int k = 0; k < 6; ++k) { const int t = lane + 64 * k, idx = 383 - t; tab[t] = rb[idx < 319 ? idx : 319]; }
        cval = rb[319]; }
    else { slope2 = exp2f(-0.5f * (float)(h + 1)) * LOG2E; sink2 = ((const float*)(ws + WS_SINK))[h]; }
    int cur = 0;
    for (int u = ubase; u < 520; u += 64) {
        const size_t qrow = (size_t)u * 64 + i;
        const int un = u + 64; const bool has_next = un < 520;
        AT_STORE(pbase + cur * BUFB);
        AT_SYNC();
        f32x16 o0, o1;
#pragma unroll
        for (int r = 0; r < 16; ++r) { o0[r] = 0.f; o1[r] = 0.f; }
        float m = -1e30f, l = 0.f;
        asm volatile("" :: "v"(q[0]), "v"(q[1]), "v"(q[2]), "v"(q[3]), "v"(cval), "v"(slope2), "v"(sink2));
        for (int j = AT_J0(u); j < NP; ++j) {
            { AT_SRC(u, j + 1, Kb, kstr, Vb, vstr); AT_LOAD(Kb, kstr, khs, Vb, vstr); }
            const int bias_base = (ISA ? 575 : 128) + i - 64 * j - 4 * hi;
            attn_tile<ISA, HG>(pbase + cur * BUFB, hl, q, o0, o1, m, l, bias_base, j < 4, cval, slope2, tab, r32, hi);
            AT_STORE(pbase + (cur ^ 1) * BUFB);
            AT_SYNC();
            cur ^= 1;
        }
        u32x2 gv[8]; bf16x8 qn[4];
        { const bf16_t* gp = Z + ((size_t)(gcol >> 6) * NTOK + qrow) * 64 + 4 * hi;
#pragma unroll
          for (int t = 0; t < 8; ++t) gv[t] = __builtin_nontemporal_load((const u32x2*)(gp + (t >> 2) * 32 + 8 * (t & 3)));
          const bf16_t* qp = Z + ((size_t)(qcol >> 6) * NTOK + qrow + (has_next ? 4096 : 0)) * 64 + 8 * hi;
#pragma unroll
          for (int d0 = 0; d0 < 4; ++d0) qn[d0] = __builtin_nontemporal_load((const bf16x8*)(qp + 16 * d0)); }
        { const int uu = has_next ? un : u; const int jn = AT_J0(uu); AT_SRC(uu, jn, Kb, kstr, Vb, vstr); AT_LOAD(Kb, kstr, khs, Vb, vstr); }
        { int bias_base = (ISA ? 575 : 128) + i - 64 * NP - 4 * hi; asm volatile("" : "+v"(bias_base));
          attn_tile<ISA, HG>(pbase + cur * BUFB, hl, q, o0, o1, m, l, bias_base, false, cval, slope2, tab, r32, hi); }
        AT_SYNC();
        cur ^= 1;
        const float lt = l + __shfl_xor(l, 32);
        float scale;
        if (ISA) scale = 1.0f / lt;
        else { const float mf = fmaxf(m, sink2), a = ex2(m - mf); scale = a / (lt * a + ex2(sink2 - mf)); }
        bf16_t* op = O + qrow * DM + ocol + 4 * hi;
#pragma unroll
        for (int t = 0; t < 8; ++t) {
            const int dblk = t >> 2, g = t & 3;
            float gg[4] = {__uint_as_float(gv[t].x << 16), __uint_as_float(gv[t].x & 0xffff0000u), __uint_as_float(gv[t].y << 16), __uint_as_float(gv[t].y & 0xffff0000u)};
            float ov[4];
#pragma unroll
            for (int e = 0; e < 4; ++e) { const float x = gg[e], sg = x * __builtin_amdgcn_rcpf(1.0f + ex2(-x * LOG2E));
                ov[e] = (dblk ? o1[4 * g + e] : o0[4 * g + e]) * scale * sg; }
            u32x2 w; w.x = cvt_pk(ov[0], ov[1]); w.y = cvt_pk(ov[2], ov[3]);
            *(u32x2*)(op + dblk * 32 + 8 * g) = w;
        }
#pragma unroll
        for (int d0 = 0; d0 < 4; ++d0) q[d0] = qn[d0];
    }
    if (PAIR) __syncthreads();
#undef AT_SRC
#undef AT_J0
#undef AT_LOAD
#undef AT_STORE
#undef AT_SYNC
}
__device__ __forceinline__ void attn_phase(const Params& p, LAS unsigned char* lds) {
    int tid_ = threadIdx.x; asm volatile("" : "+v"(tid_));
    const int tid = tid_, lane = tid & 63, wave = __builtin_amdgcn_readfirstlane(tid >> 6);
    const int G = gridDim.x, bx = blockIdx.x;
    unsigned char* ws = fresh_params()->ws;
    for (int vb = bx; vb < 256; vb += G) attn_stream<true, true>(ws, vb, lds, tid, lane, wave);
    for (int vb = bx; vb < 256; vb += G) attn_stream<false, false>(ws, 255 - vb, lds, tid, lane, wave);
}

__device__ __forceinline__ void phase4(const Params& p) {
    int tid_ = threadIdx.x; asm volatile("" : "+v"(tid_));
    const int tid = tid_, lane = tid & 63, wave = __builtin_amdgcn_readfirstlane(tid >> 6);
    const int gw = blockIdx.x * 8 + wave, NGW = gridDim.x * 8;
    kparams_t kp = fresh_params(); unsigned char* ws4 = kp->ws; float* out4 = kp->out;
    const float* pss = (const float*)(ws4 + WS_PSS);
    f32x4 g[8];
#pragma unroll
    for (int j = 0; j < 8; ++j) g[j] = ((const f32x4*)(ws4 + WS_GF))[lane + 64 * j];
    for (int m = NTOKP + gw; m < NTOK; m += NGW) {
        const f32x4* ys = (const f32x4*)((const float*)(ws4 + WS_XS) + (size_t)(m - NTOKP) * DM) + lane;
        f32x4 v[8]; float s = 0.f;
#pragma unroll
        for (int j = 0; j < 8; ++j) v[j] = ys[64 * j];
#pragma unroll 1
        for (int ks = 0; ks < 8; ++ks) { const f32x4* ps = (const f32x4*)((const float*)(ws4 + WS_PS) + ((size_t)ks * 512 + (m - NTOKP)) * DM) + lane;
#pragma unroll
            for (int j = 0; j < 8; ++j) v[j] += ps[64 * j]; }
#pragma unroll
        for (int j = 0; j < 8; ++j) s += (v[j][0] * v[j][0] + v[j][1] * v[j][1]) + (v[j][2] * v[j][2] + v[j][3] * v[j][3]);
        s = wave_sum(s);
        const float r = 1.0f / sqrtf(s * (1.0f / DM) + RMS_EPS);
        f32x4* y = (f32x4*)(out4 + (size_t)m * DM) + lane;
#pragma unroll
        for (int j = 0; j < 8; ++j) y[64 * j] = v[j] * r * g[j];
    }
    for (int m = gw; m < NTOKP; m += NGW) {
        float s = (lane < 32) ? pss[(size_t)m * 32 + lane] : 0.f;
        s = wave_sum(s);
        const float r = 1.0f / sqrtf(s * (1.0f / DM) + RMS_EPS);
        const u32x2* yb = (const u32x2*)((const bf16_t*)(ws4 + WS_Z) + (size_t)m * DM) + lane;
        f32x4* y = (f32x4*)(out4 + (size_t)m * DM) + lane;
        u32x2 t[8];
#pragma unroll
        for (int j = 0; j < 8; ++j) t[j] = __builtin_nontemporal_load(&yb[64 * j]);
#pragma unroll
        for (int j = 0; j < 8; ++j) { f32x4 v = {__uint_as_float(t[j].x << 16), __uint_as_float(t[j].x & 0xffff0000u), __uint_as_float(t[j].y << 16), __uint_as_float(t[j].y & 0xffff0000u)};
            __builtin_nontemporal_store(v * r * g[j], &y[64 * j]); }
    }
}

#ifndef MK_N_LAUNCHES
#define MK_N_LAUNCHES 1
#endif
#if MK_N_LAUNCHES != 1
#error "this file is the one-launch kernel: the phase seams are in-kernel barriers (the one-launch-per-phase cut of the first versions no longer exists)"
#endif
__global__ void __launch_bounds__(512, 2) mk_fwd(Params p) {
    extern __shared__ __attribute__((aligned(16))) unsigned char lds_raw[];
    LAS unsigned char* lds = (LAS unsigned char*)lds_raw;
    unsigned char* ws = p.ws;
#ifndef PH_MASK
#define PH_MASK 31
#endif
#if MK_N_LAUNCHES == 1
#define IN(k) ((PH_MASK >> (k)) & 1)
#else
#define IN(k) (((PH_MASK >> (k)) & 1) && p.ph_lo <= (k) && (k) < p.ph_hi)
#endif
#ifndef REP_MASK
#define REP_MASK 0
#endif
#define REPS(k) (((REP_MASK >> (k)) & 1) ? 2 : 1)
#define GSYNC0() cg::this_grid().sync()
#define GSYNC() do { XcdBarrier xb_; xb_.bar = (unsigned*)(fresh_params()->ws + WS_BAR); xb_.x = xb_xcc_id(); xb_.st = (volatile LAS unsigned*)(lds + MISC_OFF); xcd_barrier(xb_); } while (0)
    if (threadIdx.x < 16) ((volatile LAS unsigned*)(lds + MISC_OFF))[threadIdx.x] = 0u;
    __syncthreads();
    if (blockIdx.x == 0) for (int i = threadIdx.x; i < XCD_BAR_WORDS; i += 512) ((unsigned*)(ws + WS_BAR))[i] = 0u;
    GSYNC0();
    (void)xcd_barrier_post((unsigned*)(fresh_params()->ws + WS_BAR), (volatile LAS unsigned*)(lds + MISC_OFF));
    if (IN(0)) for (int rep = 0; rep < REPS(0); ++rep) { phase0(p, lds); GSYNC(); }
    if (IN(1)) for (int rep = 0; rep < REPS(1); ++rep) {
        { pg8::Gemm g{(const bf16_t*)(ws + WS_XB), (const bf16_t*)(ws + WS_W1T), NTOK, LDZ, DM, DM}; pg8::StaticOrder S; S.init(NTOK, LDZ, (int)gridDim.x, (int)blockIdx.x);
          pg8::EpiZ E{(bf16_t*)(ws + WS_Z), (const float*)(ws + WS_RS), p.out};
          pg8::gemm_phase<pg8::EpiZ, pg8::StaticOrder, true, true>(lds, g, S, E); }
        { pg8::Gemm g{(const bf16_t*)(ws + WS_W1T) + (size_t)LDZ * DM, (const bf16_t*)(ws + WS_XB), NVC, NTOK, DM, DM}; pg8::StaticOrder S; S.init(NVC, NTOK, (int)gridDim.x, (int)(gridDim.x - 1 - blockIdx.x));
          pg8::EpiVt E{(bf16_t*)(ws + WS_VT), (const float*)(ws + WS_RS), p.out};
          pg8::gemm_phase<pg8::EpiVt, pg8::StaticOrder, true, true>(lds, g, S, E); }
        { const int G = (int)gridDim.x, bx = (int)blockIdx.x;
          if (G == 256) { if (bx < 118) cache_phase(lds, bx, 204); else if (bx >= 170) cache_phase(lds, bx - 52, 204); }
          else cache_phase(lds, bx, G); }
        GSYNC();
    }
    if (IN(2)) for (int rep = 0; rep < REPS(2); ++rep) { attn_phase(p, lds); GSYNC(); }
    for (int rep = 0; rep < REPS(3); ++rep) {
    if (IN(3)) {
        kparams_t kp = fresh_params(); unsigned char* ws = kp->ws;
        { pg8::Gemm g{(const bf16_t*)(ws + WS_O), (const bf16_t*)(ws + WS_W2T), NTOKP, DM, DM, DM}; pg8::StaticOrder S; S.init(NTOKP, DM, (int)gridDim.x, (int)blockIdx.x);
          pg8::EpiY E{kp->in[0], (const float*)(ws + WS_XS), (bf16_t*)(ws + WS_Z), (float*)(ws + WS_PSS)};
          pg8::gemm_phase<pg8::EpiY, pg8::StaticOrder, true, true>(lds, g, S, E); }
        { pg8::Gemm g{(const bf16_t*)(ws + WS_O), (const bf16_t*)(ws + WS_W2T), NTOK, DM, 256, DM}; pg8::SplitK8 S{(int)gridDim.x, (int)(gridDim.x - 1 - blockIdx.x)};
          pg8::EpiYS E{(float*)(ws + WS_PS)};
          pg8::gemm_phase<pg8::EpiYS, pg8::SplitK8, false, true>(lds, g, S, E); }
        GSYNC();
    }
    if (IN(4)) { phase4(p); if (rep + 1 < REPS(3)) GSYNC(); }
    }
#undef IN
}

extern "C" void kernel_launch(void* const* d_in, const int* in_sizes, int n_in, void* d_out, int out_size, void* d_ws, size_t ws_size, hipStream_t stream) {
    static int grid = 0;
    if (grid == 0) {
        if (n_in != 12 || ws_size < WS_END) { fprintf(stderr, "kernel_launch: bad arguments (n_in %d, ws %zu < %zu)\n", n_in, ws_size, (size_t)WS_END); grid = -1; return; }
        int dev = 0, cus = 0, per_cu = 0;
        if (hipGetDevice(&dev) != hipSuccess || hipDeviceGetAttribute(&cus, hipDeviceAttributeMultiprocessorCount, dev) != hipSuccess) { grid = -1; return; }
        if (hipFuncSetAttribute((const void*)mk_fwd, hipFuncAttributeMaxDynamicSharedMemorySize, LDS_BYTES) != hipSuccess) { fprintf(stderr, "kernel_launch: hipFuncSetAttribute failed\n"); grid = -1; return; }
        if (hipOccupancyMaxActiveBlocksPerMultiprocessor(&per_cu, (const void*)mk_fwd, 512, LDS_BYTES) != hipSuccess || per_cu < 1) { fprintf(stderr, "kernel_launch: occupancy query failed (%d)\n", per_cu); grid = -1; return; }
        grid = cus * per_cu;
    }
    if (grid < 0) return;
    Params p{};
    for (int i = 0; i < 12; ++i) p.in[i] = (const float*)d_in[i];
    p.out = (float*)d_out; p.ws = (unsigned char*)d_ws;
#if MK_N_LAUNCHES == 1
    p.ph_lo = 0; p.ph_hi = 5;
    void* args[] = {&p};
    hipError_t e = hipLaunchCooperativeKernel((const void*)mk_fwd, dim3(grid), dim3(512), args, LDS_BYTES, stream);
    if (e != hipSuccess) fprintf(stderr, "cooperative launch failed: %s (grid %d)\n", hipGetErrorString(e), grid);
#else
    for (int li = 0; li < 5; ++li) { p.ph_lo = li; p.ph_hi = li + 1; hipLaunchKernelGGL(mk_fwd, dim3(grid), dim3(512), LDS_BYTES, stream, p); }
#endif
}
```

```cpp
#include <hip/hip_runtime.h>
#include <hip/hip_cooperative_groups.h>
#include <cstdio>
#include <cstdint>
namespace cg = cooperative_groups;

#define LAS __attribute__((address_space(3)))
typedef unsigned short bf16_t;
typedef short bf16x8 __attribute__((ext_vector_type(8)));
typedef float f32x4 __attribute__((ext_vector_type(4)));
typedef float f32x16 __attribute__((ext_vector_type(16)));
typedef unsigned u32x4 __attribute__((ext_vector_type(4)));
typedef unsigned u32x2 __attribute__((ext_vector_type(2)));

constexpr int DM = 2048, NTOKP = 32768, NTOK = 33280;
constexpr int LDZ = 5376;
constexpr size_t ZHS = (size_t)33280 * 64;
constexpr int NVC = 1280, LDV = NTOK;
constexpr float LOG2E = 1.4426950408889634f;
constexpr float C2 = 0.125f * LOG2E;
constexpr float RMS_EPS = 1e-6f;
constexpr size_t OFF_AKP = 68157440, OFF_AVP = 69206016, OFF_BKP = 70254592, OFF_BVP = 70320128,
                 OFF_AKS = 70385664, OFF_AVS = 74579968, OFF_BKS = 78774272, OFF_BVS = 79036416;
constexpr size_t MiB = 1u << 20;
constexpr size_t WS_XB = 0, WS_O = 0, WS_W1T = 130 * MiB, WS_W2T = 156 * MiB, WS_Z = 164 * MiB, WS_VT = WS_Z + 357826560,
                 WS_CAK = WS_VT + 85196800, WS_CAVT = WS_CAK + 8 * MiB, WS_CBK = WS_CAVT + 8 * MiB, WS_CBVT = WS_CBK + MiB / 2,
                 WS_RS = WS_CBVT + MiB / 2, WS_PSS = WS_RS + MiB, WS_XS = WS_PSS + 5 * MiB, WS_TAB = WS_XS + 4 * MiB, WS_SINK = WS_TAB + 32768, WS_GF = WS_SINK + 4096, WS_PS = WS_GF + 8192, WS_BAR = WS_PS + 32 * MiB, WS_END = WS_BAR + 16384;
constexpr int MISC_OFF = 159744, LDS_BYTES = 159744 + 64;

struct Params { const float* in[12]; float* out; unsigned char* ws; int ph_lo, ph_hi; };

__device__ __forceinline__ unsigned cvt_pk(float lo, float hi) {
    typedef float f2 __attribute__((ext_vector_type(2))); typedef __bf16 b2 __attribute__((ext_vector_type(2)));
    f2 v = {lo, hi}; b2 b = __builtin_convertvector(v, b2); return __builtin_bit_cast(unsigned, b);
}
__device__ __forceinline__ float bf2f(unsigned short b) { return __uint_as_float((unsigned)b << 16); }
__device__ __forceinline__ float wave_sum(float v) {
#pragma unroll
    for (int o = 1; o < 64; o <<= 1) v += __shfl_xor(v, o);
    return v;
}
#define LDS_WAIT() asm volatile("s_waitcnt lgkmcnt(0)" ::: "memory")
typedef const __attribute__((address_space(4))) Params* kparams_t;
__device__ __forceinline__ kparams_t fresh_params() { kparams_t kp = (kparams_t)__builtin_amdgcn_kernarg_segment_ptr(); asm volatile("" : "+s"(kp)); return kp; }

#define XB_TMO      128
#define XB_XCNT(j)  (256  + 64 * (j))
#define XB_XSUB(j)  (1280 + 64 * (j))
#define XB_XGEN(j)  (2304 + 64 * (j))
#define XB_TOP      3328
#define XB_TOPGEN   3392
#define XCD_BAR_WORDS 3456
#define XB_SPIN_CAP (1u << 18)

__device__ __forceinline__ unsigned xb_ld(unsigned* p)              { return __hip_atomic_load(p, __ATOMIC_RELAXED, __HIP_MEMORY_SCOPE_AGENT); }
__device__ __forceinline__ unsigned xb_add(unsigned* p, unsigned v) { return __hip_atomic_fetch_add(p, v, __ATOMIC_RELAXED, __HIP_MEMORY_SCOPE_AGENT); }
__device__ __forceinline__ unsigned xb_xcc_id() { return (unsigned)__builtin_amdgcn_s_getreg((3 << 11) | 20) & 0xFu; }
#define XB_SPIN(cond, bar) do { unsigned _sp = 0; while (cond) { __builtin_amdgcn_s_sleep(1); \
    if ((++_sp & 255u) == 0u) { if (xb_ld(&(bar)[XB_TMO])) break; if (_sp > XB_SPIN_CAP) { atomicAdd(&(bar)[XB_TMO], 1u); break; } } } } while (0)

struct XcdBarrier {
    unsigned* bar; unsigned x;
    volatile LAS unsigned* st;
};

__device__ __forceinline__ XcdBarrier xcd_barrier_post(unsigned* bar, volatile LAS unsigned* st) {
    XcdBarrier b; b.bar = bar; b.x = xb_xcc_id(); b.st = st;
    if (threadIdx.x == 0) (void)xb_add(&bar[XB_XCNT(b.x)], 1u);
    return b;
}
__device__ __forceinline__ void xcd_barrier_complete(unsigned* bar, unsigned x, unsigned& nloc, unsigned& nx) {
    const unsigned G = gridDim.x * gridDim.y * gridDim.z;
    unsigned sum, cnt, mine, sp = 0u;
    for (;;) {
        sum = 0u; cnt = 0u; mine = 0u;
#pragma unroll
        for (unsigned j = 0; j < 16; ++j) { const unsigned c = xb_ld(&bar[XB_XCNT(j)]); sum += c; cnt += (c > 0u) ? 1u : 0u; mine = (j == x) ? c : mine; }
        if (sum == G) break;
        __builtin_amdgcn_s_sleep(1);
        if ((++sp & 255u) == 0u) { if (xb_ld(&bar[XB_TMO])) break; if (sp > XB_SPIN_CAP) { atomicAdd(&bar[XB_TMO], 1u); break; } }
    }
    nloc = mine > 0u ? mine : 1u; nx = cnt > 0u ? cnt : 1u;
}

__device__ __forceinline__ void xcd_barrier(const XcdBarrier& b) {
    asm volatile("s_waitcnt vmcnt(0)" ::: "memory");
    __syncthreads();
    if (threadIdx.x == 0) {
        unsigned* bar = b.bar;
        __builtin_amdgcn_s_waitcnt(0);
        unsigned nloc = b.st[0], nx = b.st[1];
        if (nloc == 0u) { xcd_barrier_complete(bar, b.x, nloc, nx); b.st[0] = nloc; b.st[1] = nx; }
        const unsigned old = xb_add(&bar[XB_XSUB(b.x)], 1u);
        const unsigned gen = old / nloc;
        if (old + 1u == (gen + 1u) * nloc) {
            __builtin_amdgcn_fence(__ATOMIC_RELEASE, "agent");
            asm volatile("s_waitcnt vmcnt(0)" ::: "memory");
            const unsigned og = xb_add(&bar[XB_TOP], 1u);
            const unsigned tg = og / nx;
            if (og + 1u == (tg + 1u) * nx) xb_add(&bar[XB_TOPGEN], 1u);
            else XB_SPIN(xb_ld(&bar[XB_TOPGEN]) == tg, bar);
            __builtin_amdgcn_fence(__ATOMIC_ACQUIRE, "agent");
            xb_add(&bar[XB_XGEN(b.x)], 1u);
            asm volatile("s_waitcnt vmcnt(0)" ::: "memory");
        } else {
            XB_SPIN(xb_ld(&bar[XB_XGEN(b.x)]) == gen, bar);
            __builtin_amdgcn_fence(__ATOMIC_ACQUIRE, "agent");
            asm volatile("s_waitcnt vmcnt(0)" ::: "memory");
        }
    }
    __syncthreads();
}


namespace pg8 {
#define PG8_LAS __attribute__((address_space(3)))
typedef unsigned short bf16_t;
typedef short bf16x8 __attribute__((ext_vector_type(8)));
typedef float f32x4 __attribute__((ext_vector_type(4)));
typedef unsigned u32x4 __attribute__((ext_vector_type(4)));
constexpr int BM = 256, BK = 64, HALF = 128, HTB = HALF * BK * 2  , STAGE_BYTES = 8 * HTB, NXCD = 8, WGM = 8;

__host__ __device__ __forceinline__ int lds_byte(int r, int c) { const int st = (r >> 4) * 2 + (c >> 5), rr = r & 15, cc = c & 31, ob = rr * 64 + cc * 2; return st * 1024 + (ob ^ (((ob >> 9) & 1) << 5)); }
__host__ __device__ __forceinline__ void stage_rc(int b, int& R, int& C) { const int st = b / 1024, sb = b % 1024, swz = sb ^ (((sb >> 9) & 1) << 5); R = (st >> 1) * 16 + swz / 64; C = (st & 1) * 32 + (swz % 64) / 2; }
__host__ __device__ __forceinline__ int perm32(int rho) { const int n = rho >> 4, i = rho & 15; return 8 * (i >> 2) + 4 * n + (i & 3); }

struct Unit { int pm, pn, ko; };
struct Gemm { const bf16_t* A; const bf16_t* Bt; int M, N, K, ld; };

struct StaticOrder {
    int nM, nN, nwg, G, c;
    __host__ __device__ __forceinline__ void init(int M, int N, int G_, int c_) { nM = M / BM; nN = N / BM; nwg = nM * nN; G = G_; c = c_; }
    __host__ __device__ __forceinline__ bool next(int i, Unit& u) const {
        const long L = (long)i * G + c; if (L >= nwg) return false;
        int wgid = (int)L; { const int q = nwg / NXCD, r = nwg % NXCD, xcd = wgid % NXCD, off = wgid / NXCD; wgid = (xcd < r ? xcd * (q + 1) : r * (q + 1) + (xcd - r) * q) + off; }
        const int nig = WGM * nN, gid = wgid / nig, fm = gid * WGM, gsz = (nM - fm) < WGM ? (nM - fm) : WGM;
        u.pm = fm + ((wgid % nig) % gsz); u.pn = (wgid % nig) / gsz; u.ko = 0; return true;
    }
    __device__ __forceinline__ void a_ready(const Unit&) const {}
    __device__ __forceinline__ void done(const Unit&) const {}
};

}
namespace pg8 {
struct EpiZ {
    static constexpr bool PERM = true, AFTER_DRAIN = false;
    bf16_t* Z; const float* rs; float* out;
    __device__ __forceinline__ void operator()(const f32x4 (&acc)[2][2][4][2], const Unit& u, int wr, int wc, int fr, int fq) const {
        const int row0 = u.pm * BM + wr * 64 + fr;
        const int col0 = u.pn * BM + wc * 32 + 8 * fq;
        const bool isKa = (u.pn >= 4 && u.pn < 8), isKb = (u.pn == 16);
        const bool ctile = (isKa || isKb) && (u.pm >= 128 || (u.pm & 63) >= 62);
#pragma unroll
        for (int ai = 0; ai < 2; ++ai)
#pragma unroll
            for (int m = 0; m < 4; ++m) {
                const int r = row0 + ai * HALF + m * 16;
#pragma unroll
                for (int bj = 0; bj < 2; ++bj) {
                    const f32x4 v0 = acc[ai][bj][m][0], v1 = acc[ai][bj][m][1];
                    u32x4 w; w.x = cvt_pk(v0[0], v0[1]); w.y = cvt_pk(v0[2], v0[3]); w.z = cvt_pk(v1[0], v1[1]); w.w = cvt_pk(v1[2], v1[3]);
                    { const int cc = col0 + bj * HALF; *(u32x4*)(Z + ((size_t)(cc >> 6) * NTOK + r) * 64 + (cc & 63)) = w; }
                    if (ctile) {
                        float* dst = nullptr; const int c = col0 + bj * HALF;
                        if (r >= NTOKP) { const int sidx = r - NTOKP, b = sidx >> 6, i = sidx & 63;
                            dst = isKa ? out + OFF_AKS + ((size_t)(b * 512 + 448 + i) * 1024 + (c - 1024)) : out + OFF_BKS + ((size_t)(b * 128 + 64 + i) * 256 + (c - 4096)); }
                        else { const int b = r >> 14, t = r & 16383;
                            if (isKa) { if (t >= 15872) dst = out + OFF_AKP + ((size_t)(b * 512 + t - 15872) * 1024 + (c - 1024)); }
                            else      { if (t >= 16256) dst = out + OFF_BKP + ((size_t)(b * 128 + t - 16256) * 256 + (c - 4096)); } }
                        if (dst) { *(f32x4*)dst = v0; *(f32x4*)(dst + 4) = v1; }
                    }
                }
            }
    }
};
struct EpiVt {
    static constexpr bool PERM = true, AFTER_DRAIN = false;
    bf16_t* VT; const float* rs; float* out;
    __device__ __forceinline__ void operator()(const f32x4 (&acc)[2][2][4][2], const Unit& u, int wr, int wc, int fr, int fq) const {
        const int row0 = u.pm * BM + wr * 64 + fr;
        const int tok0 = u.pn * BM + wc * 32 + 8 * fq;
        const bool ctile = (u.pn >= 128 || (u.pn & 63) >= 62);
#pragma unroll
        for (int ai = 0; ai < 2; ++ai)
#pragma unroll
            for (int m = 0; m < 4; ++m) {
                const int r = row0 + ai * HALF + m * 16;
#pragma unroll
                for (int bj = 0; bj < 2; ++bj) {
                    const f32x4 v0 = acc[ai][bj][m][0], v1 = acc[ai][bj][m][1];
                    u32x4 w; w.x = cvt_pk(v0[0], v0[1]); w.y = cvt_pk(v0[2], v0[3]); w.z = cvt_pk(v1[0], v1[1]); w.w = cvt_pk(v1[2], v1[3]);
                    { const int tk0 = tok0 + bj * HALF; *(u32x4*)(VT + ((size_t)(tk0 >> 6) * NVC + r) * 64 + (tk0 & 63)) = w; }
                    if (ctile) {
#pragma unroll
                        for (int e = 0; e < 8; ++e) {
                            const int tk = tok0 + bj * HALF + e; const float val = e < 4 ? v0[e & 3] : v1[e & 3];
                            if (tk >= NTOKP) { const int sidx = tk - NTOKP, b = sidx >> 6, i = sidx & 63;
                                if (r < 1024) out[OFF_AVS + (size_t)(b * 512 + 448 + i) * 1024 + r] = val;
                                else          out[OFF_BVS + (size_t)(b * 128 + 64 + i) * 256 + (r - 1024)] = val; }
                            else { const int b = tk >> 14, t = tk & 16383;
                                if (r < 1024) { if (t >= 15872) out[OFF_AVP + (size_t)(b * 512 + t - 15872) * 1024 + r] = val; }
                                else          { if (t >= 16256) out[OFF_BVP + (size_t)(b * 128 + t - 16256) * 256 + (r - 1024)] = val; } }
                        }
                    }
                }
            }
    }
};
struct SplitK8 {
    int G, c;
    __device__ __forceinline__ bool next(int i, Unit& u) const { const int L = i * G + c; if (L >= 128) return false; const int t = L >> 3; u.pm = 128 + (t >> 3); u.pn = t & 7; u.ko = 256 * (L & 7); return true; }
    __device__ __forceinline__ void a_ready(const Unit&) const {}
    __device__ __forceinline__ void done(const Unit&) const {}
};
struct EpiYS {
    static constexpr bool PERM = false, AFTER_DRAIN = false;
    float* YS;
    __device__ __forceinline__ void operator()(const f32x4 (&acc)[2][2][4][2], const Unit& u, int wr, int wc, int fr, int fq) const {
        const int col0 = u.pn * BM + wc * 32 + 4 * fq;
#pragma unroll
        for (int ai = 0; ai < 2; ++ai)
#pragma unroll
            for (int m = 0; m < 4; ++m) {
                float* yrow = YS + ((size_t)(u.ko >> 8) * 512 + (u.pm - 128) * BM + ai * HALF + wr * 64 + m * 16 + fr) * DM + col0;
#pragma unroll
                for (int bj = 0; bj < 2; ++bj)
#pragma unroll
                    for (int n = 0; n < 2; ++n) *(f32x4*)(yrow + bj * HALF + n * 16) = acc[ai][bj][m][n];
            }
    }
};
struct EpiY {
    static constexpr bool PERM = true, AFTER_DRAIN = false;
    const float* xp; const float* xs; bf16_t* YB; float* pss;
    __device__ __forceinline__ const float* xrow(int r) const { return (r < NTOKP) ? xp + (size_t)r * DM : xs + (size_t)(r - NTOKP) * DM; }
    __device__ __forceinline__ void operator()(const f32x4 (&acc)[2][2][4][2], const Unit& u, int wr, int wc, int fr, int fq) const {
        const int col0 = u.pn * BM + wc * 32 + 8 * fq;
        const int rbase = u.pm * BM + wr * 64 + fr;
        f32x4 xv[2][2];
        { const float* xr = xrow(rbase) + col0; xv[0][0] = __builtin_nontemporal_load((const f32x4*)(xr)); xv[0][1] = __builtin_nontemporal_load((const f32x4*)(xr + 4)); }
        float q = 0.f;
#pragma unroll
        for (int s2 = 0; s2 < 16; ++s2) {
            const int g = s2 >> 1, bj = s2 & 1, ai = g >> 2, m = g & 3, cb = s2 & 1;
            if (s2 + 1 < 16) { const int g1 = (s2 + 1) >> 1, bj1 = (s2 + 1) & 1; const int r1 = rbase + (g1 >> 2) * HALF + (g1 & 3) * 16; const float* xr = xrow(r1) + col0 + bj1 * HALF;
                xv[cb ^ 1][0] = __builtin_nontemporal_load((const f32x4*)(xr)); xv[cb ^ 1][1] = __builtin_nontemporal_load((const f32x4*)(xr + 4)); }
            const int r = rbase + ai * HALF + m * 16;
            const f32x4 y0 = xv[cb][0] + acc[ai][bj][m][0], y1 = xv[cb][1] + acc[ai][bj][m][1];
            u32x4 w; w.x = cvt_pk(y0[0], y0[1]); w.y = cvt_pk(y0[2], y0[3]); w.z = cvt_pk(y1[0], y1[1]); w.w = cvt_pk(y1[2], y1[3]);
            *(u32x4*)(YB + (size_t)r * DM + col0 + bj * HALF) = w;
            q += (y0[0] * y0[0] + y0[1] * y0[1]) + (y0[2] * y0[2] + y0[3] * y0[3]) + (y1[0] * y1[0] + y1[1] * y1[1]) + (y1[2] * y1[2] + y1[3] * y1[3]);
            if (bj == 1) { q += __shfl_xor(q, 16); q += __shfl_xor(q, 32); if (fq == 0) pss[(size_t)r * 32 + u.pn * 4 + wc] = q; q = 0.f; }
        }
    }
};
}

namespace pg8 {
template <class Epi, class Sched, bool ALIGN_EPI = false, bool SP2 = false>
__device__ __forceinline__ void gemm_phase(PG8_LAS unsigned char* lds, const Gemm g, const Sched& S, const Epi& E) {
    int tid_ = threadIdx.x; asm volatile("" : "+v"(tid_)); const int tid = tid_, wid = __builtin_amdgcn_readfirstlane(tid >> 6), lane = tid & 63, wr = wid >> 2, wc = wid & 3, fr = lane & 15, fq = lane >> 4;
    const int K = g.K, nt = K / BK, LD = g.ld;
    unsigned voffA[2], voffB[2];
#pragma unroll
    for (int i = 0; i < 2; ++i) { int R, C; stage_rc(tid * 16 + i * 8192, R, C); const int Rb = Epi::PERM ? ((R & ~31) + perm32(R & 31)) : R;
        voffA[i] = (unsigned)(R * LD + C) * 2u; voffB[i] = (unsigned)(Rb * LD + C) * 2u; }
    const size_t kstep = (size_t)(BK * 2);
    const size_t hstep = (size_t)HALF * LD * 2;
    const size_t tstep = 2 * hstep;
    const unsigned ldsw = (unsigned)wid * 1024u;
    const int aoff = lds_byte(wr * 64 + fr, fq * 8), boff = lds_byte(wc * 32 + fr, fq * 8);
#define PG8_SA(b, h) (((b) * 2 + (h)) * HTB)
#define PG8_SB(b, h) ((4 + (b) * 2 + (h)) * HTB)
#define PG8_STAGE(bufoff, gbase, voff) do { _Pragma("unroll") for (int _i = 0; _i < 2; ++_i) \
        __builtin_amdgcn_global_load_lds((const unsigned*)((const char*)(gbase) + (voff)[_i]), (PG8_LAS unsigned*)(lds + (bufoff) + ldsw + _i * 8192), 16, 0, 0); } while (0)
#define PG8_LDA(dst, b, h) do { _Pragma("unroll") for (int m = 0; m < 4; ++m) _Pragma("unroll") for (int k = 0; k < 2; ++k) dst[m][k] = *(const PG8_LAS bf16x8*)(lds + PG8_SA(b, h) + aoff + m * 2048 + k * 1024); } while (0)
#define PG8_LDB(dst, b, h) do { _Pragma("unroll") for (int n = 0; n < 2; ++n) _Pragma("unroll") for (int k = 0; k < 2; ++k) dst[n][k] = *(const PG8_LAS bf16x8*)(lds + PG8_SB(b, h) + boff + n * 2048 + k * 1024); } while (0)
#define PG8_MMA(ai, bj, At, Bt) do { __builtin_amdgcn_s_setprio(1); _Pragma("unroll") for (int m = 0; m < 4; ++m) _Pragma("unroll") for (int n = 0; n < 2; ++n) _Pragma("unroll") for (int k = 0; k < 2; ++k) \
        acc[ai][bj][m][n] = __builtin_amdgcn_mfma_f32_16x16x32_bf16(Bt[n][k], At[m][k], acc[ai][bj][m][n], 0, 0, 0); __builtin_amdgcn_s_setprio(0); } while (0)
#define PG8_WAIT_V(n) asm volatile("s_waitcnt vmcnt(" #n ")" ::: "memory")
#define PG8_WAIT_L(n) asm volatile("s_waitcnt lgkmcnt(" #n ")" ::: "memory")
#define PG8_BAR __builtin_amdgcn_s_barrier()
#define PG8_SCHED __builtin_amdgcn_sched_barrier(0)
    Unit cur, nxt; int ui = 0;
    if (!S.next(0, cur)) return;
    f32x4 acc[2][2][4][2];
#pragma unroll
    for (int a = 0; a < 2; ++a)
#pragma unroll
        for (int b = 0; b < 2; ++b)
#pragma unroll
            for (int m = 0; m < 4; ++m)
#pragma unroll
                for (int n = 0; n < 2; ++n) acc[a][b][m][n] = (f32x4){0.f, 0.f, 0.f, 0.f};
    bf16x8 At[4][2], B0[2][2], B1[2][2];
    const char* cA = (const char*)g.A + (size_t)cur.pm * tstep + (size_t)cur.ko * 2; const char* cB = (const char*)g.Bt + (size_t)cur.pn * tstep + (size_t)cur.ko * 2;
    S.a_ready(cur);
    if constexpr (SP2) {
        PG8_STAGE(PG8_SB(0, 0), cB, voffB); PG8_STAGE(PG8_SB(0, 1), cB + hstep, voffB); PG8_STAGE(PG8_SA(0, 0), cA, voffA); PG8_STAGE(PG8_SA(0, 1), cA + hstep, voffA);
        if (wr == 1) PG8_BAR;
        PG8_WAIT_V(2); PG8_BAR;
        PG8_STAGE(PG8_SB(1, 0), cB + kstep, voffB); PG8_STAGE(PG8_SA(1, 0), cA + kstep, voffA); PG8_STAGE(PG8_SB(1, 1), cB + hstep + kstep, voffB);
        PG8_WAIT_V(6); PG8_BAR;
    } else {
        PG8_STAGE(PG8_SB(0, 0), cB, voffB); PG8_STAGE(PG8_SA(0, 0), cA, voffA); PG8_STAGE(PG8_SB(0, 1), cB + hstep, voffB); PG8_STAGE(PG8_SA(0, 1), cA + hstep, voffA);
        if (wr == 1) PG8_BAR;
        PG8_WAIT_V(4); PG8_BAR;
        PG8_STAGE(PG8_SB(1, 0), cB + kstep, voffB); PG8_STAGE(PG8_SA(1, 0), cA + kstep, voffA); PG8_STAGE(PG8_SB(1, 1), cB + hstep + kstep, voffB);
        PG8_WAIT_V(6); PG8_BAR;
    }
    for (;;) {
        const bool has_next = S.next(ui + 1, nxt);
        const char* nA = has_next ? (const char*)g.A + (size_t)nxt.pm * tstep + (size_t)nxt.ko * 2 : cA; const char* nB = has_next ? (const char*)g.Bt + (size_t)nxt.pn * tstep + (size_t)nxt.ko * 2 : cB;
        for (int t = 0; t < nt; t += 2) {
            const bool last = (t == nt - 2);
            const char* a1 = cA + (size_t)(t + 1) * kstep;
            const char* a2 = last ? nA : cA + (size_t)(t + 2) * kstep; const char* b2 = last ? nB : cB + (size_t)(t + 2) * kstep;
            const char* a3 = a2 + kstep; const char* b3 = b2 + kstep;
            if (last && has_next) S.a_ready(nxt);
            if constexpr (SP2) {
            PG8_LDB(B0, 0, 0); PG8_LDB(B1, 0, 1); PG8_SCHED; PG8_LDA(At, 0, 0); PG8_STAGE(PG8_SA(1, 1), a1 + hstep, voffA);
            PG8_WAIT_V(8); PG8_WAIT_L(0); PG8_BAR; PG8_MMA(0, 0, At, B0); PG8_MMA(0, 1, At, B1); PG8_BAR; PG8_SCHED;
            PG8_LDA(At, 0, 1); PG8_STAGE(PG8_SB(0, 0), b2, voffB); PG8_STAGE(PG8_SB(0, 1), b2 + hstep, voffB); PG8_STAGE(PG8_SA(0, 0), a2, voffA);
            PG8_WAIT_V(8); PG8_WAIT_L(0); PG8_BAR; PG8_MMA(1, 0, At, B0); PG8_MMA(1, 1, At, B1); PG8_BAR; PG8_SCHED;
            PG8_LDB(B0, 1, 0); PG8_LDB(B1, 1, 1); PG8_SCHED; PG8_LDA(At, 1, 0); PG8_STAGE(PG8_SA(0, 1), a2 + hstep, voffA);
            PG8_WAIT_V(8); PG8_WAIT_L(0); PG8_BAR; PG8_MMA(0, 0, At, B0); PG8_MMA(0, 1, At, B1); PG8_BAR; PG8_SCHED;
            PG8_LDA(At, 1, 1); PG8_STAGE(PG8_SB(1, 0), b3, voffB); PG8_STAGE(PG8_SB(1, 1), b3 + hstep, voffB); PG8_STAGE(PG8_SA(1, 0), a3, voffA);
            PG8_WAIT_V(8); PG8_WAIT_L(0); PG8_BAR; PG8_MMA(1, 0, At, B0); PG8_MMA(1, 1, At, B1); PG8_BAR; PG8_SCHED;
            } else {
            PG8_LDB(B0, 0, 0); PG8_SCHED; PG8_LDA(At, 0, 0); PG8_STAGE(PG8_SA(1, 1), a1 + hstep, voffA);
            PG8_WAIT_L(8); PG8_BAR; PG8_WAIT_L(0); PG8_MMA(0, 0, At, B0); PG8_BAR; PG8_SCHED;
            PG8_LDB(B1, 0, 1); PG8_STAGE(PG8_SB(0, 0), b2, voffB);
            PG8_BAR; PG8_WAIT_L(0); PG8_MMA(0, 1, At, B1); PG8_BAR;
            PG8_LDA(At, 0, 1); PG8_STAGE(PG8_SA(0, 0), a2, voffA);
            PG8_BAR; PG8_WAIT_L(0); PG8_MMA(1, 0, At, B0); PG8_BAR; PG8_SCHED;
            PG8_STAGE(PG8_SB(0, 1), b2 + hstep, voffB);
            PG8_WAIT_V(6); PG8_BAR; PG8_MMA(1, 1, At, B1); PG8_BAR;
            PG8_LDB(B0, 1, 0); PG8_SCHED; PG8_LDA(At, 1, 0); PG8_STAGE(PG8_SA(0, 1), a2 + hstep, voffA);
            PG8_WAIT_L(8); PG8_BAR; PG8_WAIT_L(0); PG8_MMA(0, 0, At, B0); PG8_BAR; PG8_SCHED;
            PG8_LDB(B1, 1, 1); PG8_STAGE(PG8_SB(1, 0), b3, voffB);
            PG8_BAR; PG8_WAIT_L(0); PG8_MMA(0, 1, At, B1); PG8_BAR;
            PG8_LDA(At, 1, 1); PG8_STAGE(PG8_SA(1, 0), a3, voffA);
            PG8_BAR; PG8_WAIT_L(0); PG8_MMA(1, 0, At, B0); PG8_BAR; PG8_SCHED;
            PG8_STAGE(PG8_SB(1, 1), b3 + hstep, voffB);
            PG8_WAIT_V(6); PG8_BAR; PG8_MMA(1, 1, At, B1); PG8_BAR;
            }
        }
        if constexpr (ALIGN_EPI) { if (wr == 0) PG8_BAR; }
        if constexpr (!Epi::AFTER_DRAIN) { E(acc, cur, wr, wc, fr, fq); S.done(cur); }
        if (!has_next) break;
#pragma unroll
        for (int a = 0; a < 2; ++a)
#pragma unroll
            for (int b = 0; b < 2; ++b)
#pragma unroll
                for (int m = 0; m < 4; ++m)
#pragma unroll
                    for (int n = 0; n < 2; ++n) acc[a][b][m][n] = (f32x4){0.f, 0.f, 0.f, 0.f};
        cur = nxt; cA = nA; cB = nB; ++ui;
        if constexpr (ALIGN_EPI) { if (wr == 1) PG8_BAR; }
    }
    PG8_WAIT_V(0);
    if constexpr (!ALIGN_EPI) { if (wr == 0) PG8_BAR; }
    PG8_BAR;
    if constexpr (Epi::AFTER_DRAIN) { E.fused(acc, cur, wr, wc, fr, fq, lds, wid, lane); S.done(cur); }
#undef PG8_SA
#undef PG8_SB
#undef PG8_STAGE
#undef PG8_LDA
#undef PG8_LDB
#undef PG8_MMA
#undef PG8_WAIT_V
#undef PG8_WAIT_L
#undef PG8_BAR
#undef PG8_SCHED
}
}
__device__ __forceinline__ void transpose_item(const float* __restrict__ W, int N, bf16_t* __restrict__ WT, int ldt, LAS float* scr, int k0, int n0, int dest_row0,
                                               const float* __restrict__ gain, float mul, int lane) {
    f32x4 v[8];
#pragma unroll
    for (int i = 0; i < 8; ++i) { const int pp = lane + 64 * i, kk = pp >> 3, c4 = pp & 7; v[i] = __builtin_nontemporal_load((const f32x4*)(W + (size_t)(k0 + kk) * N + n0 + 4 * c4)); }
#pragma unroll
    for (int i = 0; i < 8; ++i) { const int pp = lane + 64 * i, kk = pp >> 3, c4 = pp & 7; const float g = gain ? gain[k0 + kk] * mul : mul;
        LAS float* d = scr + kk * 33 + 4 * c4; d[0] = v[i][0] * g; d[1] = v[i][1] * g; d[2] = v[i][2] * g; d[3] = v[i][3] * g; }
    LDS_WAIT(); asm volatile("" ::: "memory");
    const int c = lane & 7;
#pragma unroll
    for (int j = 0; j < 4; ++j) { const int n = (lane >> 3) + 8 * j; const LAS float* s = scr + (8 * c) * 33 + n;
        u32x4 o; o.x = cvt_pk(s[0 * 33], s[1 * 33]); o.y = cvt_pk(s[2 * 33], s[3 * 33]); o.z = cvt_pk(s[4 * 33], s[5 * 33]); o.w = cvt_pk(s[6 * 33], s[7 * 33]);
        *(u32x4*)(WT + (size_t)(dest_row0 + n) * ldt + k0 + 8 * c) = o; }
    LDS_WAIT(); asm volatile("" ::: "memory");
}
__device__ __forceinline__ int permcol(int n) {
    if (n < 2048) return n;
    if (n < 3072) return 5376 + (n - 2048);
    if (n < 4096) return 2048 + (n - 3072);
    if (n < 5120) return 3072 + (n - 4096);
    if (n < 5376) return 4096 + (n - 5120);
    if (n < 5632) return 6400 + (n - 5376);
    return 4352 + (n - 5632);
}
__device__ __forceinline__ void cache_copy(const float* __restrict__ src, float* __restrict__ dstf, bf16_t* __restrict__ dstb, int rows, int rowlen, int gtid, int gthreads) {
    const int per_b = rows * rowlen, n4 = 8 * per_b / 4;
    for (int i4 = gtid; i4 < n4; i4 += gthreads) {
        const int e = i4 * 4, b = e / per_b, rem = e - b * per_b, r = rem / rowlen;
        const f32x4 v = __builtin_nontemporal_load((const f32x4*)(src + e));
        if (dstb) { u32x2 w; w.x = cvt_pk(v[0], v[1]); w.y = cvt_pk(v[2], v[3]); *(u32x2*)(dstb + e) = w; }
        if (r >= 64) __builtin_nontemporal_store(v, (f32x4*)(dstf + (size_t)b * per_b + rem - 64 * rowlen));
    }
}
__device__ __forceinline__ void phase0(const Params& p, LAS unsigned char* lds) {
    int tid_ = threadIdx.x; asm volatile("" : "+v"(tid_));
    const int tid = tid_, lane = tid & 63, wave = __builtin_amdgcn_readfirstlane(tid >> 6);
    LAS float* scr = (LAS float*)(lds + wave * 16384);
    const int gw = blockIdx.x * 8 + wave, NGW = gridDim.x * 8;
    unsigned char* ws = p.ws;
    bf16_t* W1T = (bf16_t*)(ws + WS_W1T); bf16_t* W2T = (bf16_t*)(ws + WS_W2T);
    constexpr int I_W1 = 32 * 208, I_W2 = 32 * 64;
    if (wave < 2) for (int it = blockIdx.x * 2 + wave; it < I_W1 + I_W2; it += gridDim.x * 2) {
        int r = it;
        if (r < I_W1) { const int kb = r / 208, nb = r % 208, n0 = nb * 32; const bool isq = (n0 < 1024) || (n0 >= 4096 && n0 < 5120);
            transpose_item(p.in[7], 6656, W1T, 2048, scr, kb * 64, n0, permcol(n0), p.in[6], isq ? C2 : 1.0f, lane); continue; }
        r -= I_W1;
        { const int kb = r / 64, nb = r % 64; transpose_item(p.in[10], 2048, W2T, 2048, scr, kb * 64, nb * 32, nb * 32, nullptr, 1.0f, lane); }
    }
    bf16_t* XB = (bf16_t*)(ws + WS_XB);
    if (wave >= 2) for (int m = blockIdx.x * 6 + (wave - 2); m < NTOK; m += gridDim.x * 6) {
        const float* xrow = (m < NTOKP) ? p.in[0] + (size_t)m * DM : p.in[1] + (size_t)(m - NTOKP) * DM;
        const f32x4* xr = (const f32x4*)xrow + lane;
        f32x4 v[8]; float s = 0.f;
#pragma unroll
        for (int j = 0; j < 8; ++j) { v[j] = __builtin_nontemporal_load(&xr[64 * j]); s += (v[j][0] * v[j][0] + v[j][1] * v[j][1]) + (v[j][2] * v[j][2] + v[j][3] * v[j][3]); }
        s = wave_sum(s);
        const float rr = 1.0f / sqrtf(s * (1.0f / DM) + RMS_EPS);
        u32x2* o8 = (u32x2*)(XB + (size_t)m * DM) + lane;
#pragma unroll
        for (int j = 0; j < 8; ++j) { u32x2 w; w.x = cvt_pk(v[j][0] * rr, v[j][1] * rr); w.y = cvt_pk(v[j][2] * rr, v[j][3] * rr); __builtin_nontemporal_store(w, &o8[64 * j]); }
    }
    const int gtid = blockIdx.x * 512 + tid, gthreads = gridDim.x * 512;
    for (int i = gtid; i < 16 * 320; i += gthreads) ((float*)(ws + WS_TAB))[i] = p.in[8][i] * LOG2E;
    if (gtid < 16) ((float*)(ws + WS_SINK))[gtid] = p.in[9][gtid] * LOG2E;
    for (int i = gtid; i < DM; i += gthreads) ((float*)(ws + WS_GF))[i] = p.in[11][i];
    for (int i = gtid; i < 512 * DM / 4; i += gthreads) ((f32x4*)(ws + WS_XS))[i] = ((const f32x4*)p.in[1])[i];
}

__device__ __forceinline__ void cache_phase(LAS unsigned char* lds, int w, int nw) {
    int tid_ = threadIdx.x; asm volatile("" : "+v"(tid_));
    const int tid = tid_, lane = tid & 63, wave = __builtin_amdgcn_readfirstlane(tid >> 6);
    kparams_t kp = fresh_params(); unsigned char* ws = kp->ws; float* out = kp->out;
    const float* cak = kp->in[2]; const float* cav = kp->in[3]; const float* cbk = kp->in[4]; const float* cbv = kp->in[5];
    LAS float* scr = (LAS float*)(lds + wave * 16384);
    constexpr int I_CAV = 8 * 8 * 32, I_CBV = 8 * 2 * 8;
    for (int r = w * 8 + wave; r < I_CAV + I_CBV; r += nw * 8) {
        if (r < I_CAV) { const int b = r >> 8, q = r & 255, kb = q >> 5, nb = q & 31;
            transpose_item(cav + (size_t)b * 512 * 1024, 1024, (bf16_t*)(ws + WS_CAVT) + (size_t)b * 1024 * 512, 512, scr, kb * 64, nb * 32, nb * 32, nullptr, 1.0f, lane); }
        else { const int r2 = r - I_CAV, b = r2 >> 4, q = r2 & 15, kb = q >> 3, nb = q & 7;
            transpose_item(cbv + (size_t)b * 128 * 256, 256, (bf16_t*)(ws + WS_CBVT) + (size_t)b * 256 * 128, 128, scr, kb * 64, nb * 32, nb * 32, nullptr, 1.0f, lane); }
    }
    const int gtid = w * 512 + tid, gthreads = nw * 512;
    cache_copy(cak, out + OFF_AKS, (bf16_t*)(ws + WS_CAK), 512, 1024, gtid, gthreads);
    cache_copy(cav, out + OFF_AVS, nullptr, 512, 1024, gtid, gthreads);
    cache_copy(cbk, out + OFF_BKS, (bf16_t*)(ws + WS_CBK), 128, 256, gtid, gthreads);
    cache_copy(cbv, out + OFF_BVS, nullptr, 128, 256, gtid, gthreads);
}

#define MFMA32(a, b, c) __builtin_amdgcn_mfma_f32_32x32x16_bf16((a), (b), (c), 0, 0, 0)
__device__ __forceinline__ float ex2(float x) { return __builtin_amdgcn_exp2f(x); }
constexpr int AT_BUFB = 70656, AT_VROW = 144, AT_TAB = 2 * AT_BUFB;

template <int HG>
__device__ __forceinline__ void at_load(u32x4 (&kr)[HG], u32x4 (&vr)[HG], const bf16_t* __restrict__ Kb, int kstr, size_t khs, const bf16_t* __restrict__ Vb, int vstr, int tid) {
#pragma unroll
    for (int i = 0; i < HG; ++i) { const int pp = tid + 512 * i; const int row = pp / (HG * 8), c16 = pp % (HG * 8);
        kr[i] = *(const u32x4*)(Kb + (size_t)(c16 >> 3) * khs + (size_t)row * kstr + (c16 & 7) * 8); }
#pragma unroll
    for (int i = 0; i < HG; ++i) { const int pp = tid + 512 * i; const int row = pp >> 3, c16 = pp & 7;
        vr[i] = *(const u32x4*)(Vb + (size_t)row * vstr + c16 * 8); }
}
template <int HG>
__device__ __forceinline__ void at_store(const u32x4 (&kr)[HG], const u32x4 (&vr)[HG], LAS unsigned char* buf, int tid) {
    constexpr int RS = HG * 128 + 16, KB = 64 * RS;
#pragma unroll
    for (int i = 0; i < HG; ++i) { const int pp = tid + 512 * i; const int row = pp / (HG * 8), c16 = pp % (HG * 8);
        *(LAS u32x4*)(buf + row * RS + c16 * 16) = kr[i]; }
#pragma unroll
    for (int i = 0; i < HG; ++i) { const int pp = tid + 512 * i; const int row = pp >> 3, c16 = pp & 7;
        LAS unsigned char* d = buf + KB + row * AT_VROW + ((c16 & ~1) * 2 + (c16 & 1)) * 8;
        *(LAS u32x2*)(d) = (u32x2){vr[i].x, vr[i].y}; *(LAS u32x2*)(d + 16) = (u32x2){vr[i].z, vr[i].w}; }
}

constexpr int PR_BUFB = 9216 + 64 * AT_VROW, PR_PAIRB = 2 * PR_BUFB, PR_TAB = 4 * PR_PAIRB;
__device__ __forceinline__ void at_load_p(u32x4 (&kr)[4], u32x4 (&vr)[4], const bf16_t* __restrict__ Kb, int kstr, const bf16_t* __restrict__ Vb, int vstr, int ptid) {
#pragma unroll
    for (int i = 0; i < 4; ++i) { const int pp = ptid + 128 * i, row = pp >> 3, c16 = pp & 7; kr[i] = *(const u32x4*)(Kb + (size_t)row * kstr + c16 * 8); }
#pragma unroll
    for (int i = 0; i < 4; ++i) { const int pp = ptid + 128 * i, row = pp >> 3, c16 = pp & 7; vr[i] = *(const u32x4*)(Vb + (size_t)row * vstr + c16 * 8); }
}
__device__ __forceinline__ void at_store_p(const u32x4 (&kr)[4], const u32x4 (&vr)[4], LAS unsigned char* buf, int ptid) {
#pragma unroll
    for (int i = 0; i < 4; ++i) { const int pp = ptid + 128 * i, row = pp >> 3, c16 = pp & 7; *(LAS u32x4*)(buf + row * 144 + c16 * 16) = kr[i]; }
#pragma unroll
    for (int i = 0; i < 4; ++i) { const int pp = ptid + 128 * i, row = pp >> 3, c16 = pp & 7;
        LAS unsigned char* d = buf + 9216 + row * AT_VROW + ((c16 & ~1) * 2 + (c16 & 1)) * 8;
        *(LAS u32x2*)(d) = (u32x2){vr[i].x, vr[i].y}; *(LAS u32x2*)(d + 16) = (u32x2){vr[i].z, vr[i].w}; }
}
__device__ __forceinline__ void pair_sync(volatile LAS unsigned* cnt, unsigned& ep, int lane) {
    asm volatile("s_waitcnt lgkmcnt(0)" ::: "memory");
    ep += 2u;
    if (lane == 0) __hip_atomic_fetch_add((LAS unsigned*)cnt, 1u, __ATOMIC_RELAXED, __HIP_MEMORY_SCOPE_WORKGROUP);
    while (*cnt < ep) __builtin_amdgcn_s_sleep(1);
    asm volatile("" ::: "memory");
}

template <bool ISA, int HG>
__device__ __forceinline__ void attn_tile(const LAS unsigned char* buf, int hl, const bf16x8 (&q)[4], f32x16& o0, f32x16& o1, float& m, float& l,
                                          int bias_base, bool cbias, float cval, float slope2, const LAS float* tab, int r32, int hi) {
    constexpr int RS = HG * 128 + 16, KB = 64 * RS;
    const LAS unsigned char* kp = buf + r32 * RS + (hl * 64 + 8 * hi) * 2;
    bf16x8 k0[4], k1[4];
#pragma unroll
    for (int d0 = 0; d0 < 4; ++d0) { k0[d0] = *(const LAS bf16x8*)(kp + 32 * d0); k1[d0] = *(const LAS bf16x8*)(kp + 32 * RS + 32 * d0); }
    f32x16 s0, s1;
    if (ISA) {
        if (cbias) {
#pragma unroll
            for (int r = 0; r < 16; ++r) { s0[r] = 0.f; s1[r] = 0.f; }
        } else {
            const LAS float* tb = tab + (383 - bias_base);
#pragma unroll
            for (int r = 0; r < 16; ++r) { const int off = (r & 3) + 8 * (r >> 2); s0[r] = tb[off]; s1[r] = tb[off + 32]; }
        }
    } else {
#pragma unroll
        for (int r = 0; r < 16; ++r) { const int off = (r & 3) + 8 * (r >> 2); const int d = bias_base - off;
            s0[r] = -slope2 * fabsf((float)d); s1[r] = -slope2 * fabsf((float)(d - 32)); }
    }
#pragma unroll
    for (int d0 = 0; d0 < 4; ++d0) { s0 = MFMA32(k0[d0], q[d0], s0); s1 = MFMA32(k1[d0], q[d0], s1); }
    float mx;
    { float m4[4];
#pragma unroll
      for (int k = 0; k < 4; ++k) { m4[k] = fmaxf(fmaxf(s0[k], s1[k]), s0[k + 4]); m4[k] = fmaxf(fmaxf(m4[k], s1[k + 4]), s0[k + 8]); m4[k] = fmaxf(fmaxf(m4[k], s1[k + 8]), s0[k + 12]); m4[k] = fmaxf(m4[k], s1[k + 12]); }
      mx = fmaxf(fmaxf(m4[0], m4[1]), fmaxf(m4[2], m4[3])); }
    { auto rr = __builtin_amdgcn_permlane32_swap(__float_as_uint(mx), __float_as_uint(mx), false, false); mx = fmaxf(__uint_as_float(rr[0]), __uint_as_float(rr[1])); }
    const float csh = (ISA && cbias) ? cval : 0.f;
    mx += csh;
    if (__builtin_amdgcn_ballot_w64(mx > m + 8.0f) != 0ull) {
        const float mn = fmaxf(m, mx), alpha = ex2(m - mn); m = mn; l *= alpha;
#pragma unroll
        for (int r = 0; r < 16; ++r) { o0[r] *= alpha; o1[r] *= alpha; }
    }
    { const float mr = m - csh;
#pragma unroll
      for (int r = 0; r < 16; ++r) { s0[r] = ex2(s0[r] - mr); s1[r] = ex2(s1[r] - mr); } }
    { float a4[4];
#pragma unroll
      for (int k = 0; k < 4; ++k) {
          float t0 = s0[k] + s1[k], t1 = s0[k + 4] + s1[k + 4], t2 = s0[k + 8] + s1[k + 8], t3 = s0[k + 12] + s1[k + 12];
          asm volatile("" : "+v"(t0), "+v"(t1), "+v"(t2), "+v"(t3));
          float u0 = t0 + t1, u1 = t2 + t3; asm volatile("" : "+v"(u0), "+v"(u1));
          a4[k] = u0 + u1; asm volatile("" : "+v"(a4[k])); }
      float w0 = a4[0] + a4[1], w1 = a4[2] + a4[3]; asm volatile("" : "+v"(w0), "+v"(w1));
      l += w0 + w1; }
    bf16x8 pf[4];
#pragma unroll
    for (int ks = 0; ks < 4; ++ks) { u32x4 w;
        if (ks < 2) { const int b = 8 * ks; w.x = cvt_pk(s0[b], s0[b + 1]); w.y = cvt_pk(s0[b + 2], s0[b + 3]); w.z = cvt_pk(s0[b + 4], s0[b + 5]); w.w = cvt_pk(s0[b + 6], s0[b + 7]); }
        else { const int b = 8 * (ks - 2); w.x = cvt_pk(s1[b], s1[b + 1]); w.y = cvt_pk(s1[b + 2], s1[b + 3]); w.z = cvt_pk(s1[b + 4], s1[b + 5]); w.w = cvt_pk(s1[b + 6], s1[b + 7]); }
        pf[ks] = __builtin_bit_cast(bf16x8, w); }
    __builtin_amdgcn_sched_barrier(0);
    const LAS unsigned char* vp0 = buf + KB + (hl * 64 + r32) * AT_VROW + 16 * hi;
    const LAS unsigned char* vp1 = vp0 + 32 * AT_VROW;
    u32x4 va[2][4];
#pragma unroll
    for (int ks = 0; ks < 4; ++ks) { va[0][ks] = *(const LAS u32x4*)(vp0 + 32 * ks); va[1][ks] = *(const LAS u32x4*)(vp1 + 32 * ks); }
    __builtin_amdgcn_sched_barrier(0);
#pragma unroll
    for (int ks = 0; ks < 4; ++ks) {
        o0 = MFMA32(__builtin_bit_cast(bf16x8, va[0][ks]), pf[ks], o0); o1 = MFMA32(__builtin_bit_cast(bf16x8, va[1][ks]), pf[ks], o1); }
}

template <bool ISA, bool PAIR>
__device__ __forceinline__ void attn_stream(unsigned char* ws, int vb, LAS unsigned char* lds, int tid, int lane, int wave) {
    static_assert(ISA || !PAIR, "pair mode is for type A");
    constexpr int HG = PAIR ? 1 : (ISA ? 4 : 1), NP = ISA ? 8 : 2, NKR = PAIR ? 4 : HG;
    const int ptid = tid & 127, pr = wave >> 1;
    LAS unsigned char* const pbase = PAIR ? lds + pr * PR_PAIRB : lds;
    constexpr int BUFB = PAIR ? PR_BUFB : AT_BUFB;
    volatile LAS unsigned* const pcnt = (volatile LAS unsigned*)(lds + MISC_OFF + 16) + pr; unsigned ep = 0u;
    if (PAIR) { __syncthreads(); if (lane == 0 && (wave & 1) == 0) *pcnt = 0u; __syncthreads(); }
#define AT_LOAD(Kb, kstr, khs, Vb, vstr) do { if constexpr (PAIR) at_load_p(kr, vr, Kb, kstr, Vb, vstr, ptid); else at_load<HG>(kr, vr, Kb, kstr, khs, Vb, vstr, tid); } while (0)
#define AT_STORE(buf) do { if constexpr (PAIR) at_store_p(kr, vr, buf, ptid); else at_store<HG>(kr, vr, buf, tid); } while (0)
#define AT_SYNC() do { if constexpr (PAIR) pair_sync(pcnt, ep, lane); else __syncthreads(); } while (0)
    const int r32 = lane & 31, hi = lane >> 5;
    const bf16_t* Z = (const bf16_t*)(ws + WS_Z); const bf16_t* VT = (const bf16_t*)(ws + WS_VT); bf16_t* O = (bf16_t*)(ws + WS_O);
    const int gidx = vb & 3, ubase = 32 * ((vb >> 2) & 1) + (vb >> 3);
    const int hl = (ISA && !PAIR) ? (wave >> 1) : 0, h = gidx * 4 + (wave >> 1), qblk = wave & 1;
    const int i = qblk * 32 + r32;
    const int qcol = ISA ? h * 64 : 3072 + h * 64, gcol = ISA ? 2048 + h * 64 : 4352 + h * 64, ocol = ISA ? h * 64 : 1024 + h * 64;
    const int hoff = PAIR ? pr * 64 : 0;
    const int kcol = (ISA ? 1024 + gidx * 256 : 4096 + gidx * 64) + hoff, vrow = (ISA ? gidx * 256 : 1024 + gidx * 64) + hoff;
    LAS float* tab = (LAS float*)(lds + (PAIR ? PR_TAB : AT_TAB)) + wave * 384;
    u32x4 kr[NKR], vr[NKR];
#define AT_J0(uu) (((uu) >= 512) ? 0 : ((((uu) & 255) < NP) ? NP - ((uu) & 255) : 0))
#define AT_SRC(uu, j, Kb, kstr, Vb, vstr) \
    const bf16_t* Kb; int kstr; size_t khs; const bf16_t* Vb; int vstr; \
    if ((uu) >= 512 && (j) < NP) { const int b_ = (uu) - 512; \
        if (ISA) { Kb = (const bf16_t*)(ws + WS_CAK) + ((size_t)(b_ * 512 + (j) * 64) * 1024 + gidx * 256 + hoff); kstr = 1024; khs = 64; \
                   Vb = (const bf16_t*)(ws + WS_CAVT) + ((size_t)(b_ * 1024 + gidx * 256 + hoff) * 512 + (j) * 64); vstr = 512; } \
        else     { Kb = (const bf16_t*)(ws + WS_CBK) + ((size_t)(b_ * 128 + (j) * 64) * 256 + gidx * 64); kstr = 256; khs = 64; \
                   Vb = (const bf16_t*)(ws + WS_CBVT) + ((size_t)(b_ * 256 + gidx * 64) * 128 + (j) * 64); vstr = 128; } \
    } else { const size_t R = (size_t)((uu) - NP + (j)) * 64; Kb = Z + ((size_t)(kcol >> 6) * NTOK + R) * 64; kstr = 64; khs = ZHS; Vb = VT + ((size_t)((uu) - NP + (j)) * NVC + vrow) * 64; vstr = 64; }
    { const int jf = AT_J0(ubase); AT_SRC(ubase, jf, Kb, kstr, Vb, vstr); AT_LOAD(Kb, kstr, khs, Vb, vstr); }
    bf16x8 q[4];
    { const bf16_t* qp = Z + ((size_t)(qcol >> 6) * NTOK + (size_t)ubase * 64 + i) * 64 + 8 * hi;
#pragma unroll
      for (int d0 = 0; d0 < 4; ++d0) q[d0] = *(const bf16x8*)(qp + 16 * d0); }
    float slope2 = 0.f, cval = 0.f, sink2 = 0.f;
    if (ISA) { const float* rb = (const float*)(ws + WS_TAB) + h * 320;
#pragma unroll
        for (int k = 0; k < 6; ++k) { const int t = lane + 64 * k, idx = 383 - t; tab[t] = rb[idx < 319 ? idx : 319]; }
        cval = rb[319]; }
    else { slope2 = exp2f(-0.5f * (float)(h + 1)) * LOG2E; sink2 = ((const float*)(ws + WS_SINK))[h]; }
    int cur = 0;
    for (int u = ubase; u < 520; u += 64) {
        const size_t qrow = (size_t)u * 64 + i;
        const int un = u + 64; const bool has_next = un < 520;
        AT_STORE(pbase + cur * BUFB);
        AT_SYNC();
        f32x16 o0, o1;
#pragma unroll
        for (int r = 0; r < 16; ++r) { o0[r] = 0.f; o1[r] = 0.f; }
        float m = -1e30f, l = 0.f;
        asm volatile("" :: "v"(q[0]), "v"(q[1]), "v"(q[2]), "v"(q[3]), "v"(cval), "v"(slope2), "v"(sink2));
        for (int j = AT_J0(u); j < NP; ++j) {
            { AT_SRC(u, j + 1, Kb, kstr, Vb, vstr); AT_LOAD(Kb, kstr, khs, Vb, vstr); }
            const int bias_base = (ISA ? 575 : 128) + i - 64 * j - 4 * hi;
            attn_tile<ISA, HG>(pbase + cur * BUFB, hl, q, o0, o1, m, l, bias_base, j < 4, cval, slope2, tab, r32, hi);
            AT_STORE(pbase + (cur ^ 1) * BUFB);
            AT_SYNC();
            cur ^= 1;
        }
        u32x2 gv[8]; bf16x8 qn[4];
        { const bf16_t* gp = Z + ((size_t)(gcol >> 6) * NTOK + qrow) * 64 + 4 * hi;
#pragma unroll
          for (int t = 0; t < 8; ++t) gv[t] = *(const u32x2*)(gp + (t >> 2) * 32 + 8 * (t & 3));
          const bf16_t* qp = Z + ((size_t)(qcol >> 6) * NTOK + qrow + (has_next ? 4096 : 0)) * 64 + 8 * hi;
#pragma unroll
          for (int d0 = 0; d0 < 4; ++d0) qn[d0] = *(const bf16x8*)(qp + 16 * d0); }
        { const int uu = has_next ? un : u; const int jn = AT_J0(uu); AT_SRC(uu, jn, Kb, kstr, Vb, vstr); AT_LOAD(Kb, kstr, khs, Vb, vstr); }
        { int bias_base = (ISA ? 575 : 128) + i - 64 * NP - 4 * hi; asm volatile("" : "+v"(bias_base));
          attn_tile<ISA, HG>(pbase + cur * BUFB, hl, q, o0, o1, m, l, bias_base, false, cval, slope2, tab, r32, hi); }
        AT_SYNC();
        cur ^= 1;
        const float lt = l + __shfl_xor(l, 32);
        float scale;
        if (ISA) scale = 1.0f / lt;
        else { const float mf = fmaxf(m, sink2), a = ex2(m - mf); scale = a / (lt * a + ex2(sink2 - mf)); }
        bf16_t* op = O + qrow * DM + ocol + 4 * hi;
#pragma unroll
        for (int t = 0; t < 8; ++t) {
            const int dblk = t >> 2, g = t & 3;
            float gg[4] = {__uint_as_float(gv[t].x << 16), __uint_as_float(gv[t].x & 0xffff0000u), __uint_as_float(gv[t].y << 16), __uint_as_float(gv[t].y & 0xffff0000u)};
            float ov[4];
#pragma unroll
            for (int e = 0; e < 4; ++e) { const float x = gg[e], sg = x * __builtin_amdgcn_rcpf(1.0f + ex2(-x * LOG2E));
                ov[e] = (dblk ? o1[4 * g + e] : o0[4 * g + e]) * scale * sg; }
            u32x2 w; w.x = cvt_pk(ov[0], ov[1]); w.y = cvt_pk(ov[2], ov[3]);
            *(u32x2*)(op + dblk * 32 + 8 * g) = w;
        }
#pragma unroll
        for (int d0 = 0; d0 < 4; ++d0) q[d0] = qn[d0];
    }
    if (PAIR) __syncthreads();
#undef AT_SRC
#undef AT_J0
#undef AT_LOAD
#undef AT_STORE
#undef AT_SYNC
}
__device__ __forceinline__ void attn_phase(const Params& p, LAS unsigned char* lds) {
    int tid_ = threadIdx.x; asm volatile("" : "+v"(tid_));
    const int tid = tid_, lane = tid & 63, wave = __builtin_amdgcn_readfirstlane(tid >> 6);
    const int G = gridDim.x, bx = blockIdx.x;
    unsigned char* ws = fresh_params()->ws;
    for (int vb = bx; vb < 256; vb += G) attn_stream<true, true>(ws, vb, lds, tid, lane, wave);
    for (int vb = bx; vb < 256; vb += G) attn_stream<false, false>(ws, 255 - vb, lds, tid, lane, wave);
}

__device__ __forceinline__ void phase4(const Params& p) {
    int tid_ = threadIdx.x; asm volatile("" : "+v"(tid_));
    const int tid = tid_, lane = tid & 63, wave = __builtin_amdgcn_readfirstlane(tid >> 6);
    const int gw = blockIdx.x * 8 + wave, NGW = gridDim.x * 8;
    kparams_t kp = fresh_params(); unsigned char* ws4 = kp->ws; float* out4 = kp->out;
    const float* pss = (const float*)(ws4 + WS_PSS);
    f32x4 g[8];
#pragma unroll
    for (int j = 0; j < 8; ++j) g[j] = ((const f32x4*)(ws4 + WS_GF))[lane + 64 * j];
    for (int m = NTOKP + gw; m < NTOK; m += NGW) {
        const f32x4* ys = (const f32x4*)((const float*)(ws4 + WS_XS) + (size_t)(m - NTOKP) * DM) + lane;
        f32x4 v[8]; float s = 0.f;
#pragma unroll
        for (int j = 0; j < 8; ++j) v[j] = ys[64 * j];
#pragma unroll 1
        for (int ks = 0; ks < 8; ++ks) { const f32x4* ps = (const f32x4*)((const float*)(ws4 + WS_PS) + ((size_t)ks * 512 + (m - NTOKP)) * DM) + lane;
#pragma unroll
            for (int j = 0; j < 8; ++j) v[j] += ps[64 * j]; }
#pragma unroll
        for (int j = 0; j < 8; ++j) s += (v[j][0] * v[j][0] + v[j][1] * v[j][1]) + (v[j][2] * v[j][2] + v[j][3] * v[j][3]);
        s = wave_sum(s);
        const float r = 1.0f / sqrtf(s * (1.0f / DM) + RMS_EPS);
        f32x4* y = (f32x4*)(out4 + (size_t)m * DM) + lane;
#pragma unroll
        for (int j = 0; j < 8; ++j) y[64 * j] = v[j] * r * g[j];
    }
    for (int m = gw; m < NTOKP; m += NGW) {
        float s = (lane < 32) ? pss[(size_t)m * 32 + lane] : 0.f;
        s = wave_sum(s);
        const float r = 1.0f / sqrtf(s * (1.0f / DM) + RMS_EPS);
        const u32x2* yb = (const u32x2*)((const bf16_t*)(ws4 + WS_Z) + (size_t)m * DM) + lane;
        f32x4* y = (f32x4*)(out4 + (size_t)m * DM) + lane;
        u32x2 t[8];
#pragma unroll
        for (int j = 0; j < 8; ++j) t[j] = __builtin_nontemporal_load(&yb[64 * j]);
#pragma unroll
        for (int j = 0; j < 8; ++j) { f32x4 v = {__uint_as_float(t[j].x << 16), __uint_as_float(t[j].x & 0xffff0000u), __uint_as_float(t[j].y << 16), __uint_as_float(t[j].y & 0xffff0000u)};
            __builtin_nontemporal_store(v * r * g[j], &y[64 * j]); }
    }
}

#ifndef MK_N_LAUNCHES
#define MK_N_LAUNCHES 1
#endif
#if MK_N_LAUNCHES != 1
#error "this file is the one-launch kernel: the phase seams are in-kernel barriers (the one-launch-per-phase cut of the first versions no longer exists)"
#endif
__global__ void __launch_bounds__(512, 2) mk_fwd(Params p) {
    extern __shared__ __attribute__((aligned(16))) unsigned char lds_raw[];
    LAS unsigned char* lds = (LAS unsigned char*)lds_raw;
    unsigned char* ws = p.ws;
#ifndef PH_MASK
#define PH_MASK 31
#endif
#if MK_N_LAUNCHES == 1
#define IN(k) ((PH_MASK >> (k)) & 1)
#else
#define IN(k) (((PH_MASK >> (k)) & 1) && p.ph_lo <= (k) && (k) < p.ph_hi)
#endif
#ifndef REP_MASK
#define REP_MASK 0
#endif
#define REPS(k) (((REP_MASK >> (k)) & 1) ? 2 : 1)
#define GSYNC0() cg::this_grid().sync()
#define GSYNC() do { XcdBarrier xb_; xb_.bar = (unsigned*)(fresh_params()->ws + WS_BAR); xb_.x = xb_xcc_id(); xb_.st = (volatile LAS unsigned*)(lds + MISC_OFF); xcd_barrier(xb_); } while (0)
    if (threadIdx.x < 16) ((volatile LAS unsigned*)(lds + MISC_OFF))[threadIdx.x] = 0u;
    __syncthreads();
    if (blockIdx.x == 0) for (int i = threadIdx.x; i < XCD_BAR_WORDS; i += 512) ((unsigned*)(ws + WS_BAR))[i] = 0u;
    GSYNC0();
    (void)xcd_barrier_post((unsigned*)(fresh_params()->ws + WS_BAR), (volatile LAS unsigned*)(lds + MISC_OFF));
    if (IN(0)) for (int rep = 0; rep < REPS(0); ++rep) { phase0(p, lds); GSYNC(); }
    if (IN(1)) for (int rep = 0; rep < REPS(1); ++rep) {
        { pg8::Gemm g{(const bf16_t*)(ws + WS_XB), (const bf16_t*)(ws + WS_W1T), NTOK, LDZ, DM, DM}; pg8::StaticOrder S; S.init(NTOK, LDZ, (int)gridDim.x, (int)blockIdx.x);
          pg8::EpiZ E{(bf16_t*)(ws + WS_Z), (const float*)(ws + WS_RS), p.out};
          pg8::gemm_phase<pg8::EpiZ, pg8::StaticOrder, true, true>(lds, g, S, E); }
        { pg8::Gemm g{(const bf16_t*)(ws + WS_W1T) + (size_t)LDZ * DM, (const bf16_t*)(ws + WS_XB), NVC, NTOK, DM, DM}; pg8::StaticOrder S; S.init(NVC, NTOK, (int)gridDim.x, (int)(gridDim.x - 1 - blockIdx.x));
          pg8::EpiVt E{(bf16_t*)(ws + WS_VT), (const float*)(ws + WS_RS), p.out};
          pg8::gemm_phase<pg8::EpiVt, pg8::StaticOrder, true, true>(lds, g, S, E); }
        { const int G = (int)gridDim.x, bx = (int)blockIdx.x;
          if (G == 256) { if (bx < 118) cache_phase(lds, bx, 204); else if (bx >= 170) cache_phase(lds, bx - 52, 204); }
          else cache_phase(lds, bx, G); }
        GSYNC();
    }
    if (IN(2)) for (int rep = 0; rep < REPS(2); ++rep) { attn_phase(p, lds); GSYNC(); }
    for (int rep = 0; rep < REPS(3); ++rep) {
    if (IN(3)) {
        kparams_t kp = fresh_params(); unsigned char* ws = kp->ws;
        { pg8::Gemm g{(const bf16_t*)(ws + WS_O), (const bf16_t*)(ws + WS_W2T), NTOKP, DM, DM, DM}; pg8::StaticOrder S; S.init(NTOKP, DM, (int)gridDim.x, (int)blockIdx.x);
          pg8::EpiY E{kp->in[0], (const float*)(ws + WS_XS), (bf16_t*)(ws + WS_Z), (float*)(ws + WS_PSS)};
          pg8::gemm_phase<pg8::EpiY, pg8::StaticOrder, true, true>(lds, g, S, E); }
        { pg8::Gemm g{(const bf16_t*)(ws + WS_O), (const bf16_t*)(ws + WS_W2T), NTOK, DM, 256, DM}; pg8::SplitK8 S{(int)gridDim.x, (int)(gridDim.x - 1 - blockIdx.x)};
          pg8::EpiYS E{(float*)(ws + WS_PS)};
          pg8::gemm_phase<pg8::EpiYS, pg8::SplitK8, false, true>(lds, g, S, E); }
        GSYNC();
    }
    if (IN(4)) { phase4(p); if (rep + 1 < REPS(3)) GSYNC(); }
    }
#undef IN
}

extern "C" void kernel_launch(void* const* d_in, const int* in_sizes, int n_in, void* d_out, int out_size, void* d_ws, size_t ws_size, hipStream_t stream) {
    static int grid = 0;
    if (grid == 0) {
        if (n_in != 12 || ws_size < WS_END) { fprintf(stderr, "kernel_launch: bad arguments (n_in %d, ws %zu < %zu)\n", n_in, ws_size, (size_t)WS_END); grid = -1; return; }
        int dev = 0, cus = 0, per_cu = 0;
        if (hipGetDevice(&dev) != hipSuccess || hipDeviceGetAttribute(&cus, hipDeviceAttributeMultiprocessorCount, dev) != hipSuccess) { grid = -1; return; }
        if (hipFuncSetAttribute((const void*)mk_fwd, hipFuncAttributeMaxDynamicSharedMemorySize, LDS_BYTES) != hipSuccess) { fprintf(stderr, "kernel_launch: hipFuncSetAttribute failed\n"); grid = -1; return; }
        if (hipOccupancyMaxActiveBlocksPerMultiprocessor(&per_cu, (const void*)mk_fwd, 512, LDS_BYTES) != hipSuccess || per_cu < 1) { fprintf(stderr, "kernel_launch: occupancy query failed (%d)\n", per_cu); grid = -1; return; }
        grid = cus * per_cu;
    }
    if (grid < 0) return;
    Params p{};
    for (int i = 0; i < 12; ++i) p.in[i] = (const float*)d_in[i];
    p.out = (float*)d_out; p.ws = (unsigned char*)d_ws;
#if MK_N_LAUNCHES == 1
    p.ph_lo = 0; p.ph_hi = 5;
    void* args[] = {&p};
    hipError_t e = hipLaunchCooperativeKernel((const void*)mk_fwd, dim3(grid), dim3(512), args, LDS_BYTES, stream);
    if (e != hipSuccess) fprintf(stderr, "cooperative launch failed: %s (grid %d)\n", hipGetErrorString(e), grid);
#else
    for (int li = 0; li < 5; ++li) { p.ph_lo = li; p.ph_hi = li + 1; hipLaunchKernelGGL(mk_fwd, dim3(grid), dim3(512), LDS_BYTES, stream, p); }
#endif
}
```

```cpp
#include <hip/hip_runtime.h>
#include <hip/hip_cooperative_groups.h>
#include <cstdio>
#include <cstdint>
namespace cg = cooperative_groups;

#define LAS __attribute__((address_space(3)))
typedef unsigned short bf16_t;
typedef short bf16x8 __attribute__((ext_vector_type(8)));
typedef float f32x4 __attribute__((ext_vector_type(4)));
typedef float f32x16 __attribute__((ext_vector_type(16)));
typedef unsigned u32x4 __attribute__((ext_vector_type(4)));
typedef unsigned u32x2 __attribute__((ext_vector_type(2)));

constexpr int DM = 2048, NTOKP = 32768, NTOK = 33280;
constexpr int LDZ = 5376;
constexpr size_t ZHS = (size_t)33280 * 64;
constexpr int NVC = 1280, LDV = NTOK;
constexpr float LOG2E = 1.4426950408889634f;
constexpr float C2 = 0.125f * LOG2E;
constexpr float RMS_EPS = 1e-6f;
constexpr size_t OFF_AKP = 68157440, OFF_AVP = 69206016, OFF_BKP = 70254592, OFF_BVP = 70320128,
                 OFF_AKS = 70385664, OFF_AVS = 74579968, OFF_BKS = 78774272, OFF_BVS = 79036416;
constexpr size_t MiB = 1u << 20;
constexpr size_t WS_XB = 0, WS_O = 0, WS_W1T = 130 * MiB, WS_W2T = 156 * MiB, WS_Z = 164 * MiB, WS_VT = WS_Z + 357826560,
                 WS_CAK = WS_VT + 85196800, WS_CAVT = WS_CAK + 8 * MiB, WS_CBK = WS_CAVT + 8 * MiB, WS_CBVT = WS_CBK + MiB / 2,
                 WS_RS = WS_CBVT + MiB / 2, WS_PSS = WS_RS + MiB, WS_XS = WS_PSS + 5 * MiB, WS_TAB = WS_XS + 4 * MiB, WS_SINK = WS_TAB + 32768, WS_GF = WS_SINK + 4096, WS_PS = WS_GF + 8192, WS_BAR = WS_PS + 32 * MiB, WS_END = WS_BAR + 16384;
constexpr int MISC_OFF = 159744, LDS_BYTES = 159744 + 64;

struct Params { const float* in[12]; float* out; unsigned char* ws; int ph_lo, ph_hi; };

__device__ __forceinline__ unsigned cvt_pk(float lo, float hi) {
    typedef float f2 __attribute__((ext_vector_type(2))); typedef __bf16 b2 __attribute__((ext_vector_type(2)));
    f2 v = {lo, hi}; b2 b = __builtin_convertvector(v, b2); return __builtin_bit_cast(unsigned, b);
}
__device__ __forceinline__ float bf2f(unsigned short b) { return __uint_as_float((unsigned)b << 16); }
__device__ __forceinline__ float wave_sum(float v) {
#pragma unroll
    for (int o = 1; o < 64; o <<= 1) v += __shfl_xor(v, o);
    return v;
}
#define LDS_WAIT() asm volatile("s_waitcnt lgkmcnt(0)" ::: "memory")
typedef const __attribute__((address_space(4))) Params* kparams_t;
__device__ __forceinline__ kparams_t fresh_params() { kparams_t kp = (kparams_t)__builtin_amdgcn_kernarg_segment_ptr(); asm volatile("" : "+s"(kp)); return kp; }

#define XB_TMO      128
#define XB_XCNT(j)  (256  + 64 * (j))
#define XB_XSUB(j)  (1280 + 64 * (j))
#define XB_XGEN(j)  (2304 + 64 * (j))
#define XB_TOP      3328
#define XB_TOPGEN   3392
#define XCD_BAR_WORDS 3456
#define XB_SPIN_CAP (1u << 18)

__device__ __forceinline__ unsigned xb_ld(unsigned* p)              { return __hip_atomic_load(p, __ATOMIC_RELAXED, __HIP_MEMORY_SCOPE_AGENT); }
__device__ __forceinline__ unsigned xb_add(unsigned* p, unsigned v) { return __hip_atomic_fetch_add(p, v, __ATOMIC_RELAXED, __HIP_MEMORY_SCOPE_AGENT); }
__device__ __forceinline__ unsigned xb_xcc_id() { return (unsigned)__builtin_amdgcn_s_getreg((3 << 11) | 20) & 0xFu; }
#define XB_SPIN(cond, bar) do { unsigned _sp = 0; while (cond) { __builtin_amdgcn_s_sleep(1); \
    if ((++_sp & 255u) == 0u) { if (xb_ld(&(bar)[XB_TMO])) break; if (_sp > XB_SPIN_CAP) { atomicAdd(&(bar)[XB_TMO], 1u); break; } } } } while (0)

struct XcdBarrier {
    unsigned* bar; unsigned x;
    volatile LAS unsigned* st;
};

__device__ __forceinline__ XcdBarrier xcd_barrier_post(unsigned* bar, volatile LAS unsigned* st) {
    XcdBarrier b; b.bar = bar; b.x = xb_xcc_id(); b.st = st;
    if (threadIdx.x == 0) (void)xb_add(&bar[XB_XCNT(b.x)], 1u);
    return b;
}
__device__ __forceinline__ void xcd_barrier_complete(unsigned* bar, unsigned x, unsigned& nloc, unsigned& nx) {
    const unsigned G = gridDim.x * gridDim.y * gridDim.z;
    unsigned sum, cnt, mine, sp = 0u;
    for (;;) {
        sum = 0u; cnt = 0u; mine = 0u;
#pragma unroll
        for (unsigned j = 0; j < 16; ++j) { const unsigned c = xb_ld(&bar[XB_XCNT(j)]); sum += c; cnt += (c > 0u) ? 1u : 0u; mine = (j == x) ? c : mine; }
        if (sum == G) break;
        __builtin_amdgcn_s_sleep(1);
        if ((++sp & 255u) == 0u) { if (xb_ld(&bar[XB_TMO])) break; if (sp > XB_SPIN_CAP) { atomicAdd(&bar[XB_TMO], 1u); break; } }
    }
    nloc = mine > 0u ? mine : 1u; nx = cnt > 0u ? cnt : 1u;
}

__device__ __forceinline__ void xcd_barrier(const XcdBarrier& b) {
    asm volatile("s_waitcnt vmcnt(0)" ::: "memory");
    __syncthreads();
    if (threadIdx.x == 0) {
        unsigned* bar = b.bar;
        __builtin_amdgcn_s_waitcnt(0);
        unsigned nloc = b.st[0], nx = b.st[1];
        if (nloc == 0u) { xcd_barrier_complete(bar, b.x, nloc, nx); b.st[0] = nloc; b.st[1] = nx; }
        const unsigned old = xb_add(&bar[XB_XSUB(b.x)], 1u);
        const unsigned gen = old / nloc;
        if (old + 1u == (gen + 1u) * nloc) {
            __builtin_amdgcn_fence(__ATOMIC_RELEASE, "agent");
            asm volatile("s_waitcnt vmcnt(0)" ::: "memory");
            const unsigned og = xb_add(&bar[XB_TOP], 1u);
            const unsigned tg = og / nx;
            if (og + 1u == (tg + 1u) * nx) xb_add(&bar[XB_TOPGEN], 1u);
            else XB_SPIN(xb_ld(&bar[XB_TOPGEN]) == tg, bar);
            __builtin_amdgcn_fence(__ATOMIC_ACQUIRE, "agent");
            xb_add(&bar[XB_XGEN(b.x)], 1u);
            asm volatile("s_waitcnt vmcnt(0)" ::: "memory");
        } else {
            XB_SPIN(xb_ld(&bar[XB_XGEN(b.x)]) == gen, bar);
            __builtin_amdgcn_fence(__ATOMIC_ACQUIRE, "agent");
            asm volatile("s_waitcnt vmcnt(0)" ::: "memory");
        }
    }
    __syncthreads();
}


namespace pg8 {
#define PG8_LAS __attribute__((address_space(3)))
typedef unsigned short bf16_t;
typedef short bf16x8 __attribute__((ext_vector_type(8)));
typedef float f32x4 __attribute__((ext_vector_type(4)));
typedef unsigned u32x4 __attribute__((ext_vector_type(4)));
constexpr int BM = 256, BK = 64, HALF = 128, HTB = HALF * BK * 2  , STAGE_BYTES = 8 * HTB, NXCD = 8, WGM = 8;

__host__ __device__ __forceinline__ int lds_byte(int r, int c) { const int st = (r >> 4) * 2 + (c >> 5), rr = r & 15, cc = c & 31, ob = rr * 64 + cc * 2; return st * 1024 + (ob ^ (((ob >> 9) & 1) << 5)); }
__host__ __device__ __forceinline__ void stage_rc(int b, int& R, int& C) { const int st = b / 1024, sb = b % 1024, swz = sb ^ (((sb >> 9) & 1) << 5); R = (st >> 1) * 16 + swz / 64; C = (st & 1) * 32 + (swz % 64) / 2; }
__host__ __device__ __forceinline__ int perm32(int rho) { const int n = rho >> 4, i = rho & 15; return 8 * (i >> 2) + 4 * n + (i & 3); }

struct Unit { int pm, pn, ko; };
struct Gemm { const bf16_t* A; const bf16_t* Bt; int M, N, K, ld; };

struct StaticOrder {
    int nM, nN, nwg, G, c;
    __host__ __device__ __forceinline__ void init(int M, int N, int G_, int c_) { nM = M / BM; nN = N / BM; nwg = nM * nN; G = G_; c = c_; }
    __host__ __device__ __forceinline__ bool next(int i, Unit& u) const {
        const long L = (long)i * G + c; if (L >= nwg) return false;
        int wgid = (int)L; { const int q = nwg / NXCD, r = nwg % NXCD, xcd = wgid % NXCD, off = wgid / NXCD; wgid = (xcd < r ? xcd * (q + 1) : r * (q + 1) + (xcd - r) * q) + off; }
        const int nig = WGM * nN, gid = wgid / nig, fm = gid * WGM, gsz = (nM - fm) < WGM ? (nM - fm) : WGM;
        u.pm = fm + ((wgid % nig) % gsz); u.pn = (wgid % nig) / gsz; u.ko = 0; return true;
    }
    __device__ __forceinline__ void a_ready(const Unit&) const {}
    __device__ __forceinline__ void done(const Unit&) const {}
};

}
namespace pg8 {
struct EpiZ {
    static constexpr bool PERM = true, AFTER_DRAIN = false;
    bf16_t* Z; const float* rs; float* out;
    __device__ __forceinline__ void operator()(const f32x4 (&acc)[2][2][4][2], const Unit& u, int wr, int wc, int fr, int fq) const {
        const int row0 = u.pm * BM + wr * 64 + fr;
        const int col0 = u.pn * BM + wc * 32 + 8 * fq;
        const bool isKa = (u.pn >= 4 && u.pn < 8), isKb = (u.pn == 16);
        const bool ctile = (isKa || isKb) && (u.pm >= 128 || (u.pm & 63) >= 62);
#pragma unroll
        for (int ai = 0; ai < 2; ++ai)
#pragma unroll
            for (int m = 0; m < 4; ++m) {
                const int r = row0 + ai * HALF + m * 16;
#pragma unroll
                for (int bj = 0; bj < 2; ++bj) {
                    const f32x4 v0 = acc[ai][bj][m][0], v1 = acc[ai][bj][m][1];
                    u32x4 w; w.x = cvt_pk(v0[0], v0[1]); w.y = cvt_pk(v0[2], v0[3]); w.z = cvt_pk(v1[0], v1[1]); w.w = cvt_pk(v1[2], v1[3]);
                    { const int cc = col0 + bj * HALF; *(u32x4*)(Z + ((size_t)(cc >> 6) * NTOK + r) * 64 + (cc & 63)) = w; }
                    if (ctile) {
                        float* dst = nullptr; const int c = col0 + bj * HALF;
                        if (r >= NTOKP) { const int sidx = r - NTOKP, b = sidx >> 6, i = sidx & 63;
                            dst = isKa ? out + OFF_AKS + ((size_t)(b * 512 + 448 + i) * 1024 + (c - 1024)) : out + OFF_BKS + ((size_t)(b * 128 + 64 + i) * 256 + (c - 4096)); }
                        else { const int b = r >> 14, t = r & 16383;
                            if (isKa) { if (t >= 15872) dst = out + OFF_AKP + ((size_t)(b * 512 + t - 15872) * 1024 + (c - 1024)); }
                            else      { if (t >= 16256) dst = out + OFF_BKP + ((size_t)(b * 128 + t - 16256) * 256 + (c - 4096)); } }
                        if (dst) { *(f32x4*)dst = v0; *(f32x4*)(dst + 4) = v1; }
                    }
                }
            }
    }
};
struct EpiVt {
    static constexpr bool PERM = true, AFTER_DRAIN = false;
    bf16_t* VT; const float* rs; float* out;
    __device__ __forceinline__ void operator()(const f32x4 (&acc)[2][2][4][2], const Unit& u, int wr, int wc, int fr, int fq) const {
        const int row0 = u.pm * BM + wr * 64 + fr;
        const int tok0 = u.pn * BM + wc * 32 + 8 * fq;
        const bool ctile = (u.pn >= 128 || (u.pn & 63) >= 62);
#pragma unroll
        for (int ai = 0; ai < 2; ++ai)
#pragma unroll
            for (int m = 0; m < 4; ++m) {
                const int r = row0 + ai * HALF + m * 16;
#pragma unroll
                for (int bj = 0; bj < 2; ++bj) {
                    const f32x4 v0 = acc[ai][bj][m][0], v1 = acc[ai][bj][m][1];
                    u32x4 w; w.x = cvt_pk(v0[0], v0[1]); w.y = cvt_pk(v0[2], v0[3]); w.z = cvt_pk(v1[0], v1[1]); w.w = cvt_pk(v1[2], v1[3]);
                    { const int tk0 = tok0 + bj * HALF; *(u32x4*)(VT + ((size_t)(tk0 >> 6) * NVC + r) * 64 + (tk0 & 63)) = w; }
                    if (ctile) {
#pragma unroll
                        for (int e = 0; e < 8; ++e) {
                            const int tk = tok0 + bj * HALF + e; const float val = e < 4 ? v0[e & 3] : v1[e & 3];
                            if (tk >= NTOKP) { const int sidx = tk - NTOKP, b = sidx >> 6, i = sidx & 63;
                                if (r < 1024) out[OFF_AVS + (size_t)(b * 512 + 448 + i) * 1024 + r] = val;
                                else          out[OFF_BVS + (size_t)(b * 128 + 64 + i) * 256 + (r - 1024)] = val; }
                            else { const int b = tk >> 14, t = tk & 16383;
                                if (r < 1024) { if (t >= 15872) out[OFF_AVP + (size_t)(b * 512 + t - 15872) * 1024 + r] = val; }
                                else          { if (t >= 16256) out[OFF_BVP + (size_t)(b * 128 + t - 16256) * 256 + (r - 1024)] = val; } }
                        }
                    }
                }
            }
    }
};
struct SplitK8 {
    int G, c;
    __device__ __forceinline__ bool next(int i, Unit& u) const { const int L = i * G + c; if (L >= 128) return false; const int t = L >> 3; u.pm = 128 + (t >> 3); u.pn = t & 7; u.ko = 256 * (L & 7); return true; }
    __device__ __forceinline__ void a_ready(const Unit&) const {}
    __device__ __forceinline__ void done(const Unit&) const {}
};
struct EpiYS {
    static constexpr bool PERM = false, AFTER_DRAIN = false;
    float* YS;
    __device__ __forceinline__ void operator()(const f32x4 (&acc)[2][2][4][2], const Unit& u, int wr, int wc, int fr, int fq) const {
        const int col0 = u.pn * BM + wc * 32 + 4 * fq;
#pragma unroll
        for (int ai = 0; ai < 2; ++ai)
#pragma unroll
            for (int m = 0; m < 4; ++m) {
                float* yrow = YS + ((size_t)(u.ko >> 8) * 512 + (u.pm - 128) * BM + ai * HALF + wr * 64 + m * 16 + fr) * DM + col0;
#pragma unroll
                for (int bj = 0; bj < 2; ++bj)
#pragma unroll
                    for (int n = 0; n < 2; ++n) *(f32x4*)(yrow + bj * HALF + n * 16) = acc[ai][bj][m][n];
            }
    }
};
struct EpiY {
    static constexpr bool PERM = true, AFTER_DRAIN = false;
    const float* xp; const float* xs; bf16_t* YB; float* pss;
    __device__ __forceinline__ const float* xrow(int r) const { return (r < NTOKP) ? xp + (size_t)r * DM : xs + (size_t)(r - NTOKP) * DM; }
    __device__ __forceinline__ void operator()(const f32x4 (&acc)[2][2][4][2], const Unit& u, int wr, int wc, int fr, int fq) const {
        const int col0 = u.pn * BM + wc * 32 + 8 * fq;
        const int rbase = u.pm * BM + wr * 64 + fr;
        f32x4 xv[2][2];
        { const float* xr = xrow(rbase) + col0; xv[0][0] = __builtin_nontemporal_load((const f32x4*)(xr)); xv[0][1] = __builtin_nontemporal_load((const f32x4*)(xr + 4)); }
        float q = 0.f;
#pragma unroll
        for (int s2 = 0; s2 < 16; ++s2) {
            const int g = s2 >> 1, bj = s2 & 1, ai = g >> 2, m = g & 3, cb = s2 & 1;
            if (s2 + 1 < 16) { const int g1 = (s2 + 1) >> 1, bj1 = (s2 + 1) & 1; const int r1 = rbase + (g1 >> 2) * HALF + (g1 & 3) * 16; const float* xr = xrow(r1) + col0 + bj1 * HALF;
                xv[cb ^ 1][0] = __builtin_nontemporal_load((const f32x4*)(xr)); xv[cb ^ 1][1] = __builtin_nontemporal_load((const f32x4*)(xr + 4)); }
            const int r = rbase + ai * HALF + m * 16;
            const f32x4 y0 = xv[cb][0] + acc[ai][bj][m][0], y1 = xv[cb][1] + acc[ai][bj][m][1];
            u32x4 w; w.x = cvt_pk(y0[0], y0[1]); w.y = cvt_pk(y0[2], y0[3]); w.z = cvt_pk(y1[0], y1[1]); w.w = cvt_pk(y1[2], y1[3]);
            *(u32x4*)(YB + (size_t)r * DM + col0 + bj * HALF) = w;
            q += (y0[0] * y0[0] + y0[1] * y0[1]) + (y0[2] * y0[2] + y0[3] * y0[3]) + (y1[0] * y1[0] + y1[1] * y1[1]) + (y1[2] * y1[2] + y1[3] * y1[3]);
            if (bj == 1) { q += __shfl_xor(q, 16); q += __shfl_xor(q, 32); if (fq == 0) pss[(size_t)r * 32 + u.pn * 4 + wc] = q; q = 0.f; }
        }
    }
};
}

namespace pg8 {
template <class Epi, class Sched, bool ALIGN_EPI = false, bool SP2 = false>
__device__ __forceinline__ void gemm_phase(PG8_LAS unsigned char* lds, const Gemm g, const Sched& S, const Epi& E) {
    int tid_ = threadIdx.x; asm volatile("" : "+v"(tid_)); const int tid = tid_, wid = __builtin_amdgcn_readfirstlane(tid >> 6), lane = tid & 63, wr = wid >> 2, wc = wid & 3, fr = lane & 15, fq = lane >> 4;
    const int K = g.K, nt = K / BK, LD = g.ld;
    unsigned voffA[2], voffB[2];
#pragma unroll
    for (int i = 0; i < 2; ++i) { int R, C; stage_rc(tid * 16 + i * 8192, R, C); const int Rb = Epi::PERM ? ((R & ~31) + perm32(R & 31)) : R;
        voffA[i] = (unsigned)(R * LD + C) * 2u; voffB[i] = (unsigned)(Rb * LD + C) * 2u; }
    const size_t kstep = (size_t)(BK * 2);
    const size_t hstep = (size_t)HALF * LD * 2;
    const size_t tstep = 2 * hstep;
    const unsigned ldsw = (unsigned)wid * 1024u;
    const int aoff = lds_byte(wr * 64 + fr, fq * 8), boff = lds_byte(wc * 32 + fr, fq * 8);
#define PG8_SA(b, h) (((b) * 2 + (h)) * HTB)
#define PG8_SB(b, h) ((4 + (b) * 2 + (h)) * HTB)
#define PG8_STAGE(bufoff, gbase, voff) do { _Pragma("unroll") for (int _i = 0; _i < 2; ++_i) \
        __builtin_amdgcn_global_load_lds((const unsigned*)((const char*)(gbase) + (voff)[_i]), (PG8_LAS unsigned*)(lds + (bufoff) + ldsw + _i * 8192), 16, 0, 0); } while (0)
#define PG8_LDA(dst, b, h) do { _Pragma("unroll") for (int m = 0; m < 4; ++m) _Pragma("unroll") for (int k = 0; k < 2; ++k) dst[m][k] = *(const PG8_LAS bf16x8*)(lds + PG8_SA(b, h) + aoff + m * 2048 + k * 1024); } while (0)
#define PG8_LDB(dst, b, h) do { _Pragma("unroll") for (int n = 0; n < 2; ++n) _Pragma("unroll") for (int k = 0; k < 2; ++k) dst[n][k] = *(const PG8_LAS bf16x8*)(lds + PG8_SB(b, h) + boff + n * 2048 + k * 1024); } while (0)
#define PG8_MMA(ai, bj, At, Bt) do { __builtin_amdgcn_s_setprio(1); _Pragma("unroll") for (int m = 0; m < 4; ++m) _Pragma("unroll") for (int n = 0; n < 2; ++n) _Pragma("unroll") for (int k = 0; k < 2; ++k) \
        acc[ai][bj][m][n] = __builtin_amdgcn_mfma_f32_16x16x32_bf16(Bt[n][k], At[m][k], acc[ai][bj][m][n], 0, 0, 0); __builtin_amdgcn_s_setprio(0); } while (0)
#define PG8_WAIT_V(n) asm volatile("s_waitcnt vmcnt(" #n ")" ::: "memory")
#define PG8_WAIT_L(n) asm volatile("s_waitcnt lgkmcnt(" #n ")" ::: "memory")
#define PG8_BAR __builtin_amdgcn_s_barrier()
#define PG8_SCHED __builtin_amdgcn_sched_barrier(0)
    Unit cur, nxt; int ui = 0;
    if (!S.next(0, cur)) return;
    f32x4 acc[2][2][4][2];
#pragma unroll
    for (int a = 0; a < 2; ++a)
#pragma unroll
        for (int b = 0; b < 2; ++b)
#pragma unroll
            for (int m = 0; m < 4; ++m)
#pragma unroll
                for (int n = 0; n < 2; ++n) acc[a][b][m][n] = (f32x4){0.f, 0.f, 0.f, 0.f};
    bf16x8 At[4][2], B0[2][2], B1[2][2];
    const char* cA = (const char*)g.A + (size_t)cur.pm * tstep + (size_t)cur.ko * 2; const char* cB = (const char*)g.Bt + (size_t)cur.pn * tstep + (size_t)cur.ko * 2;
    S.a_ready(cur);
    if constexpr (SP2) {
        PG8_STAGE(PG8_SB(0, 0), cB, voffB); PG8_STAGE(PG8_SB(0, 1), cB + hstep, voffB); PG8_STAGE(PG8_SA(0, 0), cA, voffA); PG8_STAGE(PG8_SA(0, 1), cA + hstep, voffA);
        if (wr == 1) PG8_BAR;
        PG8_WAIT_V(2); PG8_BAR;
        PG8_STAGE(PG8_SB(1, 0), cB + kstep, voffB); PG8_STAGE(PG8_SA(1, 0), cA + kstep, voffA); PG8_STAGE(PG8_SB(1, 1), cB + hstep + kstep, voffB);
        PG8_WAIT_V(6); PG8_BAR;
    } else {
        PG8_STAGE(PG8_SB(0, 0), cB, voffB); PG8_STAGE(PG8_SA(0, 0), cA, voffA); PG8_STAGE(PG8_SB(0, 1), cB + hstep, voffB); PG8_STAGE(PG8_SA(0, 1), cA + hstep, voffA);
        if (wr == 1) PG8_BAR;
        PG8_WAIT_V(4); PG8_BAR;
        PG8_STAGE(PG8_SB(1, 0), cB + kstep, voffB); PG8_STAGE(PG8_SA(1, 0), cA + kstep, voffA); PG8_STAGE(PG8_SB(1, 1), cB + hstep + kstep, voffB);
        PG8_WAIT_V(6); PG8_BAR;
    }
    for (;;) {
        const bool has_next = S.next(ui + 1, nxt);
        const char* nA = has_next ? (const char*)g.A + (size_t)nxt.pm * tstep + (size_t)nxt.ko * 2 : cA; const char* nB = has_next ? (const char*)g.Bt + (size_t)nxt.pn * tstep + (size_t)nxt.ko * 2 : cB;
        for (int t = 0; t < nt; t += 2) {
            const bool last = (t == nt - 2);
            const char* a1 = cA + (size_t)(t + 1) * kstep;
            const char* a2 = last ? nA : cA + (size_t)(t + 2) * kstep; const char* b2 = last ? nB : cB + (size_t)(t + 2) * kstep;
            const char* a3 = a2 + kstep; const char* b3 = b2 + kstep;
            if (last && has_next) S.a_ready(nxt);
            if constexpr (SP2) {
            PG8_LDB(B0, 0, 0); PG8_LDB(B1, 0, 1); PG8_SCHED; PG8_LDA(At, 0, 0); PG8_STAGE(PG8_SA(1, 1), a1 + hstep, voffA);
            PG8_WAIT_V(8); PG8_WAIT_L(0); PG8_BAR; PG8_MMA(0, 0, At, B0); PG8_MMA(0, 1, At, B1); PG8_BAR; PG8_SCHED;
            PG8_LDA(At, 0, 1); PG8_STAGE(PG8_SB(0, 0), b2, voffB); PG8_STAGE(PG8_SB(0, 1), b2 + hstep, voffB); PG8_STAGE(PG8_SA(0, 0), a2, voffA);
            PG8_WAIT_V(8); PG8_WAIT_L(0); PG8_BAR; PG8_MMA(1, 0, At, B0); PG8_MMA(1, 1, At, B1); PG8_BAR; PG8_SCHED;
            PG8_LDB(B0, 1, 0); PG8_LDB(B1, 1, 1); PG8_SCHED; PG8_LDA(At, 1, 0); PG8_STAGE(PG8_SA(0, 1), a2 + hstep, voffA);
            PG8_WAIT_V(8); PG8_WAIT_L(0); PG8_BAR; PG8_MMA(0, 0, At, B0); PG8_MMA(0, 1, At, B1); PG8_BAR; PG8_SCHED;
            PG8_LDA(At, 1, 1); PG8_STAGE(PG8_SB(1, 0), b3, voffB); PG8_STAGE(PG8_SB(1, 1), b3 + hstep, voffB); PG8_STAGE(PG8_SA(1, 0), a3, voffA);
            PG8_WAIT_V(8); PG8_WAIT_L(0); PG8_BAR; PG8_MMA(1, 0, At, B0); PG8_MMA(1, 1, At, B1); PG8_BAR; PG8_SCHED;
            } else {
            PG8_LDB(B0, 0, 0); PG8_SCHED; PG8_LDA(At, 0, 0); PG8_STAGE(PG8_SA(1, 1), a1 + hstep, voffA);
            PG8_WAIT_L(8); PG8_BAR; PG8_WAIT_L(0); PG8_MMA(0, 0, At, B0); PG8_BAR; PG8_SCHED;
            PG8_LDB(B1, 0, 1); PG8_STAGE(PG8_SB(0, 0), b2, voffB);
            PG8_BAR; PG8_WAIT_L(0); PG8_MMA(0, 1, At, B1); PG8_BAR;
            PG8_LDA(At, 0, 1); PG8_STAGE(PG8_SA(0, 0), a2, voffA);
            PG8_BAR; PG8_WAIT_L(0); PG8_MMA(1, 0, At, B0); PG8_BAR; PG8_SCHED;
            PG8_STAGE(PG8_SB(0, 1), b2 + hstep, voffB);
            PG8_WAIT_V(6); PG8_BAR; PG8_MMA(1, 1, At, B1); PG8_BAR;
            PG8_LDB(B0, 1, 0); PG8_SCHED; PG8_LDA(At, 1, 0); PG8_STAGE(PG8_SA(0, 1), a2 + hstep, voffA);
            PG8_WAIT_L(8); PG8_BAR; PG8_WAIT_L(0); PG8_MMA(0, 0, At, B0); PG8_BAR; PG8_SCHED;
            PG8_LDB(B1, 1, 1); PG8_STAGE(PG8_SB(1, 0), b3, voffB);
            PG8_BAR; PG8_WAIT_L(0); PG8_MMA(0, 1, At, B1); PG8_BAR;
            PG8_LDA(At, 1, 1); PG8_STAGE(PG8_SA(1, 0), a3, voffA);
            PG8_BAR; PG8_WAIT_L(0); PG8_MMA(1, 0, At, B0); PG8_BAR; PG8_SCHED;
            PG8_STAGE(PG8_SB(1, 1), b3 + hstep, voffB);
            PG8_WAIT_V(6); PG8_BAR; PG8_MMA(1, 1, At, B1); PG8_BAR;
            }
        }
        if constexpr (ALIGN_EPI) { if (wr == 0) PG8_BAR; }
        if constexpr (!Epi::AFTER_DRAIN) { E(acc, cur, wr, wc, fr, fq); S.done(cur); }
        if (!has_next) break;
#pragma unroll
        for (int a = 0; a < 2; ++a)
#pragma unroll
            for (int b = 0; b < 2; ++b)
#pragma unroll
                for (int m = 0; m < 4; ++m)
#pragma unroll
                    for (int n = 0; n < 2; ++n) acc[a][b][m][n] = (f32x4){0.f, 0.f, 0.f, 0.f};
        cur = nxt; cA = nA; cB = nB; ++ui;
        if constexpr (ALIGN_EPI) { if (wr == 1) PG8_BAR; }
    }
    PG8_WAIT_V(0);
    if constexpr (!ALIGN_EPI) { if (wr == 0) PG8_BAR; }
    PG8_BAR;
    if constexpr (Epi::AFTER_DRAIN) { E.fused(acc, cur, wr, wc, fr, fq, lds, wid, lane); S.done(cur); }
#undef PG8_SA
#undef PG8_SB
#undef PG8_STAGE
#undef PG8_LDA
#undef PG8_LDB
#undef PG8_MMA
#undef PG8_WAIT_V
#undef PG8_WAIT_L
#undef PG8_BAR
#undef PG8_SCHED
}
}
__device__ __forceinline__ void transpose_item(const float* __restrict__ W, int N, bf16_t* __restrict__ WT, int ldt, LAS float* scr, int k0, int n0, int dest_row0,
                                               const float* __restrict__ gain, float mul, int lane) {
    f32x4 v[8];
#pragma unroll
    for (int i = 0; i < 8; ++i) { const int pp = lane + 64 * i, kk = pp >> 3, c4 = pp & 7; v[i] = __builtin_nontemporal_load((const f32x4*)(W + (size_t)(k0 + kk) * N + n0 + 4 * c4)); }
#pragma unroll
    for (int i = 0; i < 8; ++i) { const int pp = lane + 64 * i, kk = pp >> 3, c4 = pp & 7; const float g = gain ? gain[k0 + kk] * mul : mul;
        LAS float* d = scr + kk * 33 + 4 * c4; d[0] = v[i][0] * g; d[1] = v[i][1] * g; d[2] = v[i][2] * g; d[3] = v[i][3] * g; }
    LDS_WAIT(); asm volatile("" ::: "memory");
    const int c = lane & 7;
#pragma unroll
    for (int j = 0; j < 4; ++j) { const int n = (lane >> 3) + 8 * j; const LAS float* s = scr + (8 * c) * 33 + n;
        u32x4 o; o.x = cvt_pk(s[0 * 33], s[1 * 33]); o.y = cvt_pk(s[2 * 33], s[3 * 33]); o.z = cvt_pk(s[4 * 33], s[5 * 33]); o.w = cvt_pk(s[6 * 33], s[7 * 33]);
        *(u32x4*)(WT + (size_t)(dest_row0 + n) * ldt + k0 + 8 * c) = o; }
    LDS_WAIT(); asm volatile("" ::: "memory");
}
__device__ __forceinline__ int permcol(int n) {
    if (n < 2048) return n;
    if (n < 3072) return 5376 + (n - 2048);
    if (n < 4096) return 2048 + (n - 3072);
    if (n < 5120) return 3072 + (n - 4096);
    if (n < 5376) return 4096 + (n - 5120);
    if (n < 5632) return 6400 + (n - 5376);
    return 4352 + (n - 5632);
}
__device__ __forceinline__ void cache_copy(const float* __restrict__ src, float* __restrict__ dstf, bf16_t* __restrict__ dstb, int rows, int rowlen, int gtid, int gthreads) {
    const int per_b = rows * rowlen, n4 = 8 * per_b / 4;
    for (int i4 = gtid; i4 < n4; i4 += gthreads) {
        const int e = i4 * 4, b = e / per_b, rem = e - b * per_b, r = rem / rowlen;
        const f32x4 v = __builtin_nontemporal_load((const f32x4*)(src + e));
        if (dstb) { u32x2 w; w.x = cvt_pk(v[0], v[1]); w.y = cvt_pk(v[2], v[3]); *(u32x2*)(dstb + e) = w; }
        if (r >= 64) __builtin_nontemporal_store(v, (f32x4*)(dstf + (size_t)b * per_b + rem - 64 * rowlen));
    }
}
__device__ __forceinline__ void phase0(const Params& p, LAS unsigned char* lds) {
    int tid_ = threadIdx.x; asm volatile("" : "+v"(tid_));
    const int tid = tid_, lane = tid & 63, wave = __builtin_amdgcn_readfirstlane(tid >> 6);
    LAS float* scr = (LAS float*)(lds + wave * 16384);
    const int gw = blockIdx.x * 8 + wave, NGW = gridDim.x * 8;
    unsigned char* ws = p.ws;
    bf16_t* W1T = (bf16_t*)(ws + WS_W1T); bf16_t* W2T = (bf16_t*)(ws + WS_W2T);
    constexpr int I_W1 = 32 * 208, I_W2 = 32 * 64;
    if (wave < 2) for (int it = blockIdx.x * 2 + wave; it < I_W1 + I_W2; it += gridDim.x * 2) {
        int r = it;
        if (r < I_W1) { const int kb = r / 208, nb = r % 208, n0 = nb * 32; const bool isq = (n0 < 1024) || (n0 >= 4096 && n0 < 5120);
            transpose_item(p.in[7], 6656, W1T, 2048, scr, kb * 64, n0, permcol(n0), p.in[6], isq ? C2 : 1.0f, lane); continue; }
        r -= I_W1;
        { const int kb = r / 64, nb = r % 64; transpose_item(p.in[10], 2048, W2T, 2048, scr, kb * 64, nb * 32, nb * 32, nullptr, 1.0f, lane); }
    }
    bf16_t* XB = (bf16_t*)(ws + WS_XB);
    if (wave >= 2) for (int m = blockIdx.x * 6 + (wave - 2); m < NTOK; m += gridDim.x * 6) {
        const float* xrow = (m < NTOKP) ? p.in[0] + (size_t)m * DM : p.in[1] + (size_t)(m - NTOKP) * DM;
        const f32x4* xr = (const f32x4*)xrow + lane;
        f32x4 v[8]; float s = 0.f;
#pragma unroll
        for (int j = 0; j < 8; ++j) { v[j] = __builtin_nontemporal_load(&xr[64 * j]); s += (v[j][0] * v[j][0] + v[j][1] * v[j][1]) + (v[j][2] * v[j][2] + v[j][3] * v[j][3]); }
        s = wave_sum(s);
        const float rr = 1.0f / sqrtf(s * (1.0f / DM) + RMS_EPS);
        u32x2* o8 = (u32x2*)(XB + (size_t)m * DM) + lane;
#pragma unroll
        for (int j = 0; j < 8; ++j) { u32x2 w; w.x = cvt_pk(v[j][0] * rr, v[j][1] * rr); w.y = cvt_pk(v[j][2] * rr, v[j][3] * rr); o8[64 * j] = w; }
    }
    const int gtid = blockIdx.x * 512 + tid, gthreads = gridDim.x * 512;
    for (int i = gtid; i < 16 * 320; i += gthreads) ((float*)(ws + WS_TAB))[i] = p.in[8][i] * LOG2E;
    if (gtid < 16) ((float*)(ws + WS_SINK))[gtid] = p.in[9][gtid] * LOG2E;
    for (int i = gtid; i < DM; i += gthreads) ((float*)(ws + WS_GF))[i] = p.in[11][i];
    for (int i = gtid; i < 512 * DM / 4; i += gthreads) ((f32x4*)(ws + WS_XS))[i] = ((const f32x4*)p.in[1])[i];
}

__device__ __forceinline__ void cache_phase(LAS unsigned char* lds, int w, int nw) {
    int tid_ = threadIdx.x; asm volatile("" : "+v"(tid_));
    const int tid = tid_, lane = tid & 63, wave = __builtin_amdgcn_readfirstlane(tid >> 6);
    kparams_t kp = fresh_params(); unsigned char* ws = kp->ws; float* out = kp->out;
    const float* cak = kp->in[2]; const float* cav = kp->in[3]; const float* cbk = kp->in[4]; const float* cbv = kp->in[5];
    LAS float* scr = (LAS float*)(lds + wave * 16384);
    constexpr int I_CAV = 8 * 8 * 32, I_CBV = 8 * 2 * 8;
    for (int r = w * 8 + wave; r < I_CAV + I_CBV; r += nw * 8) {
        if (r < I_CAV) { const int b = r >> 8, q = r & 255, kb = q >> 5, nb = q & 31;
            transpose_item(cav + (size_t)b * 512 * 1024, 1024, (bf16_t*)(ws + WS_CAVT) + (size_t)b * 1024 * 512, 512, scr, kb * 64, nb * 32, nb * 32, nullptr, 1.0f, lane); }
        else { const int r2 = r - I_CAV, b = r2 >> 4, q = r2 & 15, kb = q >> 3, nb = q & 7;
            transpose_item(cbv + (size_t)b * 128 * 256, 256, (bf16_t*)(ws + WS_CBVT) + (size_t)b * 256 * 128, 128, scr, kb * 64, nb * 32, nb * 32, nullptr, 1.0f, lane); }
    }
    const int gtid = w * 512 + tid, gthreads = nw * 512;
    cache_copy(cak, out + OFF_AKS, (bf16_t*)(ws + WS_CAK), 512, 1024, gtid, gthreads);
    cache_copy(cav, out + OFF_AVS, nullptr, 512, 1024, gtid, gthreads);
    cache_copy(cbk, out + OFF_BKS, (bf16_t*)(ws + WS_CBK), 128, 256, gtid, gthreads);
    cache_copy(cbv, out + OFF_BVS, nullptr, 128, 256, gtid, gthreads);
}

#define MFMA32(a, b, c) __builtin_amdgcn_mfma_f32_32x32x16_bf16((a), (b), (c), 0, 0, 0)
__device__ __forceinline__ float ex2(float x) { return __builtin_amdgcn_exp2f(x); }
constexpr int AT_BUFB = 70656, AT_VROW = 144, AT_TAB = 2 * AT_BUFB;

template <int HG>
__device__ __forceinline__ void at_load(u32x4 (&kr)[HG], u32x4 (&vr)[HG], const bf16_t* __restrict__ Kb, int kstr, size_t khs, const bf16_t* __restrict__ Vb, int vstr, int tid) {
#pragma unroll
    for (int i = 0; i < HG; ++i) { const int pp = tid + 512 * i; const int row = pp / (HG * 8), c16 = pp % (HG * 8);
        kr[i] = *(const u32x4*)(Kb + (size_t)(c16 >> 3) * khs + (size_t)row * kstr + (c16 & 7) * 8); }
#pragma unroll
    for (int i = 0; i < HG; ++i) { const int pp = tid + 512 * i; const int row = pp >> 3, c16 = pp & 7;
        vr[i] = *(const u32x4*)(Vb + (size_t)row * vstr + c16 * 8); }
}
template <int HG>
__device__ __forceinline__ void at_store(const u32x4 (&kr)[HG], const u32x4 (&vr)[HG], LAS unsigned char* buf, int tid) {
    constexpr int RS = HG * 128 + 16, KB = 64 * RS;
#pragma unroll
    for (int i = 0; i < HG; ++i) { const int pp = tid + 512 * i; const int row = pp / (HG * 8), c16 = pp % (HG * 8);
        *(LAS u32x4*)(buf + row * RS + c16 * 16) = kr[i]; }
#pragma unroll
    for (int i = 0; i < HG; ++i) { const int pp = tid + 512 * i; const int row = pp >> 3, c16 = pp & 7;
        LAS unsigned char* d = buf + KB + row * AT_VROW + ((c16 & ~1) * 2 + (c16 & 1)) * 8;
        *(LAS u32x2*)(d) = (u32x2){vr[i].x, vr[i].y}; *(LAS u32x2*)(d + 16) = (u32x2){vr[i].z, vr[i].w}; }
}

constexpr int PR_BUFB = 9216 + 64 * AT_VROW, PR_PAIRB = 2 * PR_BUFB, PR_TAB = 4 * PR_PAIRB;
__device__ __forceinline__ void at_load_p(u32x4 (&kr)[4], u32x4 (&vr)[4], const bf16_t* __restrict__ Kb, int kstr, const bf16_t* __restrict__ Vb, int vstr, int ptid) {
#pragma unroll
    for (int i = 0; i < 4; ++i) { const int pp = ptid + 128 * i, row = pp >> 3, c16 = pp & 7; kr[i] = *(const u32x4*)(Kb + (size_t)row * kstr + c16 * 8); }
#pragma unroll
    for (int i = 0; i < 4; ++i) { const int pp = ptid + 128 * i, row = pp >> 3, c16 = pp & 7; vr[i] = *(const u32x4*)(Vb + (size_t)row * vstr + c16 * 8); }
}
__device__ __forceinline__ void at_store_p(const u32x4 (&kr)[4], const u32x4 (&vr)[4], LAS unsigned char* buf, int ptid) {
#pragma unroll
    for (int i = 0; i < 4; ++i) { const int pp = ptid + 128 * i, row = pp >> 3, c16 = pp & 7; *(LAS u32x4*)(buf + row * 144 + c16 * 16) = kr[i]; }
#pragma unroll
    for (int i = 0; i < 4; ++i) { const int pp = ptid + 128 * i, row = pp >> 3, c16 = pp & 7;
        LAS unsigned char* d = buf + 9216 + row * AT_VROW + ((c16 & ~1) * 2 + (c16 & 1)) * 8;
        *(LAS u32x2*)(d) = (u32x2){vr[i].x, vr[i].y}; *(LAS u32x2*)(d + 16) = (u32x2){vr[i].z, vr[i].w}; }
}
__device__ __forceinline__ void pair_sync(volatile LAS unsigned* cnt, unsigned& ep, int lane) {
    asm volatile("s_waitcnt lgkmcnt(0)" ::: "memory");
    ep += 2u;
    if (lane == 0) __hip_atomic_fetch_add((LAS unsigned*)cnt, 1u, __ATOMIC_RELAXED, __HIP_MEMORY_SCOPE_WORKGROUP);
    while (*cnt < ep) __builtin_amdgcn_s_sleep(1);
    asm volatile("" ::: "memory");
}

template <bool ISA, int HG>
__device__ __forceinline__ void attn_tile(const LAS unsigned char* buf, int hl, const bf16x8 (&q)[4], f32x16& o0, f32x16& o1, float& m, float& l,
                                          int bias_base, bool cbias, float cval, float slope2, const LAS float* tab, int r32, int hi) {
    constexpr int RS = HG * 128 + 16, KB = 64 * RS;
    const LAS unsigned char* kp = buf + r32 * RS + (hl * 64 + 8 * hi) * 2;
    bf16x8 k0[4], k1[4];
#pragma unroll
    for (int d0 = 0; d0 < 4; ++d0) { k0[d0] = *(const LAS bf16x8*)(kp + 32 * d0); k1[d0] = *(const LAS bf16x8*)(kp + 32 * RS + 32 * d0); }
    f32x16 s0, s1;
    if (ISA) {
        if (cbias) {
#pragma unroll
            for (int r = 0; r < 16; ++r) { s0[r] = 0.f; s1[r] = 0.f; }
        } else {
            const LAS float* tb = tab + (383 - bias_base);
#pragma unroll
            for (int r = 0; r < 16; ++r) { const int off = (r & 3) + 8 * (r >> 2); s0[r] = tb[off]; s1[r] = tb[off + 32]; }
        }
    } else {
#pragma unroll
        for (int r = 0; r < 16; ++r) { const int off = (r & 3) + 8 * (r >> 2); const int d = bias_base - off;
            s0[r] = -slope2 * fabsf((float)d); s1[r] = -slope2 * fabsf((float)(d - 32)); }
    }
#pragma unroll
    for (int d0 = 0; d0 < 4; ++d0) { s0 = MFMA32(k0[d0], q[d0], s0); s1 = MFMA32(k1[d0], q[d0], s1); }
    float mx;
    { float m4[4];
#pragma unroll
      for (int k = 0; k < 4; ++k) { m4[k] = fmaxf(fmaxf(s0[k], s1[k]), s0[k + 4]); m4[k] = fmaxf(fmaxf(m4[k], s1[k + 4]), s0[k + 8]); m4[k] = fmaxf(fmaxf(m4[k], s1[k + 8]), s0[k + 12]); m4[k] = fmaxf(m4[k], s1[k + 12]); }
      mx = fmaxf(fmaxf(m4[0], m4[1]), fmaxf(m4[2], m4[3])); }
    { auto rr = __builtin_amdgcn_permlane32_swap(__float_as_uint(mx), __float_as_uint(mx), false, false); mx = fmaxf(__uint_as_float(rr[0]), __uint_as_float(rr[1])); }
    const float csh = (ISA && cbias) ? cval : 0.f;
    mx += csh;
    if (__builtin_amdgcn_ballot_w64(mx > m + 8.0f) != 0ull) {
        const float mn = fmaxf(m, mx), alpha = ex2(m - mn); m = mn; l *= alpha;
#pragma unroll
        for (int r = 0; r < 16; ++r) { o0[r] *= alpha; o1[r] *= alpha; }
    }
    { const float mr = m - csh;
#pragma unroll
      for (int r = 0; r < 16; ++r) { s0[r] = ex2(s0[r] - mr); s1[r] = ex2(s1[r] - mr); } }
    { float a4[4];
#pragma unroll
      for (int k = 0; k < 4; ++k) {
          float t0 = s0[k] + s1[k], t1 = s0[k + 4] + s1[k + 4], t2 = s0[k + 8] + s1[k + 8], t3 = s0[k + 12] + s1[k + 12];
          asm volatile("" : "+v"(t0), "+v"(t1), "+v"(t2), "+v"(t3));
          float u0 = t0 + t1, u1 = t2 + t3; asm volatile("" : "+v"(u0), "+v"(u1));
          a4[k] = u0 + u1; asm volatile("" : "+v"(a4[k])); }
      float w0 = a4[0] + a4[1], w1 = a4[2] + a4[3]; asm volatile("" : "+v"(w0), "+v"(w1));
      l += w0 + w1; }
    bf16x8 pf[4];
#pragma unroll
    for (int ks = 0; ks < 4; ++ks) { u32x4 w;
        if (ks < 2) { const int b = 8 * ks; w.x = cvt_pk(s0[b], s0[b + 1]); w.y = cvt_pk(s0[b + 2], s0[b + 3]); w.z = cvt_pk(s0[b + 4], s0[b + 5]); w.w = cvt_pk(s0[b + 6], s0[b + 7]); }
        else { const int b = 8 * (ks - 2); w.x = cvt_pk(s1[b], s1[b + 1]); w.y = cvt_pk(s1[b + 2], s1[b + 3]); w.z = cvt_pk(s1[b + 4], s1[b + 5]); w.w = cvt_pk(s1[b + 6], s1[b + 7]); }
        pf[ks] = __builtin_bit_cast(bf16x8, w); }
    __builtin_amdgcn_sched_barrier(0);
    const LAS unsigned char* vp0 = buf + KB + (hl * 64 + r32) * AT_VROW + 16 * hi;
    const LAS unsigned char* vp1 = vp0 + 32 * AT_VROW;
    u32x4 va[2][4];
#pragma unroll
    for (int ks = 0; ks < 4; ++ks) { va[0][ks] = *(const LAS u32x4*)(vp0 + 32 * ks); va[1][ks] = *(const LAS u32x4*)(vp1 + 32 * ks); }
    __builtin_amdgcn_sched_barrier(0);
#pragma unroll
    for (int ks = 0; ks < 4; ++ks) {
        o0 = MFMA32(__builtin_bit_cast(bf16x8, va[0][ks]), pf[ks], o0); o1 = MFMA32(__builtin_bit_cast(bf16x8, va[1][ks]), pf[ks], o1); }
}

template <bool ISA, bool PAIR>
__device__ __forceinline__ void attn_stream(unsigned char* ws, int vb, LAS unsigned char* lds, int tid, int lane, int wave) {
    static_assert(ISA || !PAIR, "pair mode is for type A");
    constexpr int HG = PAIR ? 1 : (ISA ? 4 : 1), NP = ISA ? 8 : 2, NKR = PAIR ? 4 : HG;
    const int ptid = tid & 127, pr = wave >> 1;
    LAS unsigned char* const pbase = PAIR ? lds + pr * PR_PAIRB : lds;
    constexpr int BUFB = PAIR ? PR_BUFB : AT_BUFB;
    volatile LAS unsigned* const pcnt = (volatile LAS unsigned*)(lds + MISC_OFF + 16) + pr; unsigned ep = 0u;
    if (PAIR) { __syncthreads(); if (lane == 0 && (wave & 1) == 0) *pcnt = 0u; __syncthreads(); }
#define AT_LOAD(Kb, kstr, khs, Vb, vstr) do { if constexpr (PAIR) at_load_p(kr, vr, Kb, kstr, Vb, vstr, ptid); else at_load<HG>(kr, vr, Kb, kstr, khs, Vb, vstr, tid); } while (0)
#define AT_STORE(buf) do { if constexpr (PAIR) at_store_p(kr, vr, buf, ptid); else at_store<HG>(kr, vr, buf, tid); } while (0)
#define AT_SYNC() do { if constexpr (PAIR) pair_sync(pcnt, ep, lane); else __syncthreads(); } while (0)
    const int r32 = lane & 31, hi = lane >> 5;
    const bf16_t* Z = (const bf16_t*)(ws + WS_Z); const bf16_t* VT = (const bf16_t*)(ws + WS_VT); bf16_t* O = (bf16_t*)(ws + WS_O);
    const int gidx = vb & 3, ubase = 32 * ((vb >> 2) & 1) + (vb >> 3);
    const int hl = (ISA && !PAIR) ? (wave >> 1) : 0, h = gidx * 4 + (wave >> 1), qblk = wave & 1;
    const int i = qblk * 32 + r32;
    const int qcol = ISA ? h * 64 : 3072 + h * 64, gcol = ISA ? 2048 + h * 64 : 4352 + h * 64, ocol = ISA ? h * 64 : 1024 + h * 64;
    const int hoff = PAIR ? pr * 64 : 0;
    const int kcol = (ISA ? 1024 + gidx * 256 : 4096 + gidx * 64) + hoff, vrow = (ISA ? gidx * 256 : 1024 + gidx * 64) + hoff;
    LAS float* tab = (LAS float*)(lds + (PAIR ? PR_TAB : AT_TAB)) + wave * 384;
    u32x4 kr[NKR], vr[NKR];
#define AT_J0(uu) (((uu) >= 512) ? 0 : ((((uu) & 255) < NP) ? NP - ((uu) & 255) : 0))
#define AT_SRC(uu, j, Kb, kstr, Vb, vstr) \
    const bf16_t* Kb; int kstr; size_t khs; const bf16_t* Vb; int vstr; \
    if ((uu) >= 512 && (j) < NP) { const int b_ = (uu) - 512; \
        if (ISA) { Kb = (const bf16_t*)(ws + WS_CAK) + ((size_t)(b_ * 512 + (j) * 64) * 1024 + gidx * 256 + hoff); kstr = 1024; khs = 64; \
                   Vb = (const bf16_t*)(ws + WS_CAVT) + ((size_t)(b_ * 1024 + gidx * 256 + hoff) * 512 + (j) * 64); vstr = 512; } \
        else     { Kb = (const bf16_t*)(ws + WS_CBK) + ((size_t)(b_ * 128 + (j) * 64) * 256 + gidx * 64); kstr = 256; khs = 64; \
                   Vb = (const bf16_t*)(ws + WS_CBVT) + ((size_t)(b_ * 256 + gidx * 64) * 128 + (j) * 64); vstr = 128; } \
    } else { const size_t R = (size_t)((uu) - NP + (j)) * 64; Kb = Z + ((size_t)(kcol >> 6) * NTOK + R) * 64; kstr = 64; khs = ZHS; Vb = VT + ((size_t)((uu) - NP + (j)) * NVC + vrow) * 64; vstr = 64; }
    { const int jf = AT_J0(ubase); AT_SRC(ubase, jf, Kb, kstr, Vb, vstr); AT_LOAD(Kb, kstr, khs, Vb, vstr); }
    bf16x8 q[4];
    { const bf16_t* qp = Z + ((size_t)(qcol >> 6) * NTOK + (size_t)ubase * 64 + i) * 64 + 8 * hi;
#pragma unroll
      for (int d0 = 0; d0 < 4; ++d0) q[d0] = *(const bf16x8*)(qp + 16 * d0); }
    float slope2 = 0.f, cval = 0.f, sink2 = 0.f;
    if (ISA) { const float* rb = (const float*)(ws + WS_TAB) + h * 320;
#pragma unroll
        for (int k = 0; k < 6; ++k) { const int t = lane + 64 * k, idx = 383 - t; tab[t] = rb[idx < 319 ? idx : 319]; }
        cval = rb[319]; }
    else { slope2 = exp2f(-0.5f * (float)(h + 1)) * LOG2E; sink2 = ((const float*)(ws + WS_SINK))[h]; }
    int cur = 0;
    for (int u = ubase; u < 520; u += 64) {
        const size_t qrow = (size_t)u * 64 + i;
        const int un = u + 64; const bool has_next = un < 520;
        AT_STORE(pbase + cur * BUFB);
        AT_SYNC();
        f32x16 o0, o1;
#pragma unroll
        for (int r = 0; r < 16; ++r) { o0[r] = 0.f; o1[r] = 0.f; }
        float m = -1e30f, l = 0.f;
        asm volatile("" :: "v"(q[0]), "v"(q[1]), "v"(q[2]), "v"(q[3]), "v"(cval), "v"(slope2), "v"(sink2));
        for (int j = AT_J0(u); j < NP; ++j) {
            { AT_SRC(u, j + 1, Kb, kstr, Vb, vstr); AT_LOAD(Kb, kstr, khs, Vb, vstr); }
            const int bias_base = (ISA ? 575 : 128) + i - 64 * j - 4 * hi;
            attn_tile<ISA, HG>(pbase + cur * BUFB, hl, q, o0, o1, m, l, bias_base, j < 4, cval, slope2, tab, r32, hi);
            AT_STORE(pbase + (cur ^ 1) * BUFB);
            AT_SYNC();
            cur ^= 1;
        }
        u32x2 gv[8]; bf16x8 qn[4];
        { const bf16_t* gp = Z + ((size_t)(gcol >> 6) * NTOK + qrow) * 64 + 4 * hi;
#pragma unroll
          for (int t = 0; t < 8; ++t) gv[t] = *(const u32x2*)(gp + (t >> 2) * 32 + 8 * (t & 3));
          const bf16_t* qp = Z + ((size_t)(qcol >> 6) * NTOK + qrow + (has_next ? 4096 : 0)) * 64 + 8 * hi;
#pragma unroll
          for (int d0 = 0; d0 < 4; ++d0) qn[d0] = *(const bf16x8*)(qp + 16 * d0); }
        { const int uu = has_next ? un : u; const int jn = AT_J0(uu); AT_SRC(uu, jn, Kb, kstr, Vb, vstr); AT_LOAD(Kb, kstr, khs, Vb, vstr); }
        { int bias_base = (ISA ? 575 : 128) + i - 64 * NP - 4 * hi; asm volatile("" : "+v"(bias_base));
          attn_tile<ISA, HG>(pbase + cur * BUFB, hl, q, o0, o1, m, l, bias_base, false, cval, slope2, tab, r32, hi); }
        AT_SYNC();
        cur ^= 1;
        const float lt = l + __shfl_xor(l, 32);
        float scale;
        if (ISA) scale = 1.0f / lt;
        else { const float mf = fmaxf(m, sink2), a = ex2(m - mf); scale = a / (lt * a + ex2(sink2 - mf)); }
        bf16_t* op = O + qrow * DM + ocol + 4 * hi;
#pragma unroll
        for (int t = 0; t < 8; ++t) {
            const int dblk = t >> 2, g = t & 3;
            float gg[4] = {__uint_as_float(gv[t].x << 16), __uint_as_float(gv[t].x & 0xffff0000u), __uint_as_float(gv[t].y << 16), __uint_as_float(gv[t].y & 0xffff0000u)};
            float ov[4];
#pragma unroll
            for (int e = 0; e < 4; ++e) { const float x = gg[e], sg = x * __builtin_amdgcn_rcpf(1.0f + ex2(-x * LOG2E));
                ov[e] = (dblk ? o1[4 * g + e] : o0[4 * g + e]) * scale * sg; }
            u32x2 w; w.x = cvt_pk(ov[0], ov[1]); w.y = cvt_pk(ov[2], ov[3]);
            *(u32x2*)(op + dblk * 32 + 8 * g) = w;
        }
#pragma unroll
        for (int d0 = 0; d0 < 4; ++d0) q[d0] = qn[d0];
    }
    if (PAIR) __syncthreads();
#undef AT_SRC
#undef AT_J0
#undef AT_LOAD
#undef AT_STORE
#undef AT_SYNC
}
__device__ __forceinline__ void attn_phase(const Params& p, LAS unsigned char* lds) {
    int tid_ = threadIdx.x; asm volatile("" : "+v"(tid_));
    const int tid = tid_, lane = tid & 63, wave = __builtin_amdgcn_readfirstlane(tid >> 6);
    const int G = gridDim.x, bx = blockIdx.x;
    unsigned char* ws = fresh_params()->ws;
    for (int vb = bx; vb < 256; vb += G) attn_stream<true, true>(ws, vb, lds, tid, lane, wave);
    for (int vb = bx; vb < 256; vb += G) attn_stream<false, false>(ws, 255 - vb, lds, tid, lane, wave);
}

__device__ __forceinline__ void phase4(const Params& p) {
    int tid_ = threadIdx.x; asm volatile("" : "+v"(tid_));
    const int tid = tid_, lane = tid & 63, wave = __builtin_amdgcn_readfirstlane(tid >> 6);
    const int gw = blockIdx.x * 8 + wave, NGW = gridDim.x * 8;
    kparams_t kp = fresh_params(); unsigned char* ws4 = kp->ws; float* out4 = kp->out;
    const float* pss = (const float*)(ws4 + WS_PSS);
    f32x4 g[8];
#pragma unroll
    for (int j = 0; j < 8; ++j) g[j] = ((const f32x4*)(ws4 + WS_GF))[lane + 64 * j];
    for (int m = NTOKP + gw; m < NTOK; m += NGW) {
        const f32x4* ys = (const f32x4*)((const float*)(ws4 + WS_XS) + (size_t)(m - NTOKP) * DM) + lane;
        f32x4 v[8]; float s = 0.f;
#pragma unroll
        for (int j = 0; j < 8; ++j) v[j] = ys[64 * j];
#pragma unroll 1
        for (int ks = 0; ks < 8; ++ks) { const f32x4* ps = (const f32x4*)((const float*)(ws4 + WS_PS) + ((size_t)ks * 512 + (m - NTOKP)) * DM) + lane;
#pragma unroll
            for (int j = 0; j < 8; ++j) v[j] += ps[64 * j]; }
#pragma unroll
        for (int j = 0; j < 8; ++j) s += (v[j][0] * v[j][0] + v[j][1] * v[j][1]) + (v[j][2] * v[j][2] + v[j][3] * v[j][3]);
        s = wave_sum(s);
        const float r = 1.0f / sqrtf(s * (1.0f / DM) + RMS_EPS);
        f32x4* y = (f32x4*)(out4 + (size_t)m * DM) + lane;
#pragma unroll
        for (int j = 0; j < 8; ++j) y[64 * j] = v[j] * r * g[j];
    }
    for (int m = gw; m < NTOKP; m += NGW) {
        float s = (lane < 32) ? pss[(size_t)m * 32 + lane] : 0.f;
        s = wave_sum(s);
        const float r = 1.0f / sqrtf(s * (1.0f / DM) + RMS_EPS);
        const u32x2* yb = (const u32x2*)((const bf16_t*)(ws4 + WS_Z) + (size_t)m * DM) + lane;
        f32x4* y = (f32x4*)(out4 + (size_t)m * DM) + lane;
        u32x2 t[8];
#pragma unroll
        for (int j = 0; j < 8; ++j) t[j] = yb[64 * j];
#pragma unroll
        for (int j = 0; j < 8; ++j) { f32x4 v = {__uint_as_float(t[j].x << 16), __uint_as_float(t[j].x & 0xffff0000u), __uint_as_float(t[j].y << 16), __uint_as_float(t[j].y & 0xffff0000u)};
            __builtin_nontemporal_store(v * r * g[j], &y[64 * j]); }
    }
}

#ifndef MK_N_LAUNCHES
#define MK_N_LAUNCHES 1
#endif
#if MK_N_LAUNCHES != 1
#error "this file is the one-launch kernel: the phase seams are in-kernel barriers (the one-launch-per-phase cut of the first versions no longer exists)"
#endif
__global__ void __launch_bounds__(512, 2) mk_fwd(Params p) {
    extern __shared__ __attribute__((aligned(16))) unsigned char lds_raw[];
    LAS unsigned char* lds = (LAS unsigned char*)lds_raw;
    unsigned char* ws = p.ws;
#ifndef PH_MASK
#define PH_MASK 31
#endif
#if MK_N_LAUNCHES == 1
#define IN(k) ((PH_MASK >> (k)) & 1)
#else
#define IN(k) (((PH_MASK >> (k)) & 1) && p.ph_lo <= (k) && (k) < p.ph_hi)
#endif
#ifndef REP_MASK
#define REP_MASK 0
#endif
#define REPS(k) (((REP_MASK >> (k)) & 1) ? 2 : 1)
#define GSYNC0() cg::this_grid().sync()
#define GSYNC() do { XcdBarrier xb_; xb_.bar = (unsigned*)(fresh_params()->ws + WS_BAR); xb_.x = xb_xcc_id(); xb_.st = (volatile LAS unsigned*)(lds + MISC_OFF); xcd_barrier(xb_); } while (0)
    if (threadIdx.x < 16) ((volatile LAS unsigned*)(lds + MISC_OFF))[threadIdx.x] = 0u;
    __syncthreads();
    if (blockIdx.x == 0) for (int i = threadIdx.x; i < XCD_BAR_WORDS; i += 512) ((unsigned*)(ws + WS_BAR))[i] = 0u;
    GSYNC0();
    (void)xcd_barrier_post((unsigned*)(fresh_params()->ws + WS_BAR), (volatile LAS unsigned*)(lds + MISC_OFF));
    if (IN(0)) for (int rep = 0; rep < REPS(0); ++rep) { phase0(p, lds); GSYNC(); }
    if (IN(1)) for (int rep = 0; rep < REPS(1); ++rep) {
        { pg8::Gemm g{(const bf16_t*)(ws + WS_XB), (const bf16_t*)(ws + WS_W1T), NTOK, LDZ, DM, DM}; pg8::StaticOrder S; S.init(NTOK, LDZ, (int)gridDim.x, (int)blockIdx.x);
          pg8::EpiZ E{(bf16_t*)(ws + WS_Z), (const float*)(ws + WS_RS), p.out};
          pg8::gemm_phase<pg8::EpiZ, pg8::StaticOrder, true, true>(lds, g, S, E); }
        { pg8::Gemm g{(const bf16_t*)(ws + WS_W1T) + (size_t)LDZ * DM, (const bf16_t*)(ws + WS_XB), NVC, NTOK, DM, DM}; pg8::StaticOrder S; S.init(NVC, NTOK, (int)gridDim.x, (int)(gridDim.x - 1 - blockIdx.x));
          pg8::EpiVt E{(bf16_t*)(ws + WS_VT), (const float*)(ws + WS_RS), p.out};
          pg8::gemm_phase<pg8::EpiVt, pg8::StaticOrder, true, true>(lds, g, S, E); }
        { const int G = (int)gridDim.x, bx = (int)blockIdx.x;
          if (G == 256) { if (bx < 118) cache_phase(lds, bx, 204); else if (bx >= 170) cache_phase(lds, bx - 52, 204); }
          else cache_phase(lds, bx, G); }
        GSYNC();
    }
    if (IN(2)) for (int rep = 0; rep < REPS(2); ++rep) { attn_phase(p, lds); GSYNC(); }
    for (int rep = 0; rep < REPS(3); ++rep) {
    if (IN(3)) {
        kparams_t kp = fresh_params(); unsigned char* ws = kp->ws;
        { pg8::Gemm g{(const bf16_t*)(ws + WS_O), (const bf16_t*)(ws + WS_W2T), NTOKP, DM, DM, DM}; pg8::StaticOrder S; S.init(NTOKP, DM, (int)gridDim.x, (int)blockIdx.x);
          pg8::EpiY E{kp->in[0], (const float*)(ws + WS_XS), (bf16_t*)(ws + WS_Z), (float*)(ws + WS_PSS)};
          pg8::gemm_phase<pg8::EpiY, pg8::StaticOrder, true, true>(lds, g, S, E); }
        { pg8::Gemm g{(const bf16_t*)(ws + WS_O), (const bf16_t*)(ws + WS_W2T), NTOK, DM, 256, DM}; pg8::SplitK8 S{(int)gridDim.x, (int)(gridDim.x - 1 - blockIdx.x)};
          pg8::EpiYS E{(float*)(ws + WS_PS)};
          pg8::gemm_phase<pg8::EpiYS, pg8::SplitK8, false, true>(lds, g, S, E); }
        GSYNC();
    }
    if (IN(4)) { phase4(p); if (rep + 1 < REPS(3)) GSYNC(); }
    }
#undef IN
}

extern "C" void kernel_launch(void* const* d_in, const int* in_sizes, int n_in, void* d_out, int out_size, void* d_ws, size_t ws_size, hipStream_t stream) {
    static int grid = 0;
    if (grid == 0) {
        if (n_in != 12 || ws_size < WS_END) { fprintf(stderr, "kernel_launch: bad arguments (n_in %d, ws %zu < %zu)\n", n_in, ws_size, (size_t)WS_END); grid = -1; return; }
        int dev = 0, cus = 0, per_cu = 0;
        if (hipGetDevice(&dev) != hipSuccess || hipDeviceGetAttribute(&cus, hipDeviceAttributeMultiprocessorCount, dev) != hipSuccess) { grid = -1; return; }
        if (hipFuncSetAttribute((const void*)mk_fwd, hipFuncAttributeMaxDynamicSharedMemorySize, LDS_BYTES) != hipSuccess) { fprintf(stderr, "kernel_launch: hipFuncSetAttribute failed\n"); grid = -1; return; }
        if (hipOccupancyMaxActiveBlocksPerMultiprocessor(&per_cu, (const void*)mk_fwd, 512, LDS_BYTES) != hipSuccess || per_cu < 1) { fprintf(stderr, "kernel_launch: occupancy query failed (%d)\n", per_cu); grid = -1; return; }
        grid = cus * per_cu;
    }
    if (grid < 0) return;
    Params p{};
    for (int i = 0; i < 12; ++i) p.in[i] = (const float*)d_in[i];
    p.out = (float*)d_out; p.ws = (unsigned char*)d_ws;
#if MK_N_LAUNCHES == 1
    p.ph_lo = 0; p.ph_hi = 5;
    void* args[] = {&p};
    hipError_t e = hipLaunchCooperativeKernel((const void*)mk_fwd, dim3(grid), dim3(512), args, LDS_BYTES, stream);
    if (e != hipSuccess) fprintf(stderr, "cooperative launch failed: %s (grid %d)\n", hipGetErrorString(e), grid);
#else
    for (int li = 0; li < 5; ++li) { p.ph_lo = li; p.ph_hi = li + 1; hipLaunchKernelGGL(mk_fwd, dim3(grid), dim3(512), LDS_BYTES, stream, p); }
#endif
}
```

```cpp
#include <hip/hip_runtime.h>
#include <hip/hip_cooperative_groups.h>
#include <cstdio>
#include <cstdint>
namespace cg = cooperative_groups;

#define LAS __attribute__((address_space(3)))
typedef unsigned short bf16_t;
typedef short bf16x8 __attribute__((ext_vector_type(8)));
typedef float f32x4 __attribute__((ext_vector_type(4)));
typedef float f32x16 __attribute__((ext_vector_type(16)));
typedef unsigned u32x4 __attribute__((ext_vector_type(4)));
typedef unsigned u32x2 __attribute__((ext_vector_type(2)));

constexpr int DM = 2048, NTOKP = 32768, NTOK = 33280;
constexpr int LDZ = 5376;
constexpr size_t ZHS = (size_t)33280 * 64;
constexpr int NVC = 1280, LDV = NTOK;
constexpr float LOG2E = 1.4426950408889634f;
constexpr float C2 = 0.125f * LOG2E;
constexpr float RMS_EPS = 1e-6f;
constexpr size_t OFF_AKP = 68157440, OFF_AVP = 69206016, OFF_BKP = 70254592, OFF_BVP = 70320128,
                 OFF_AKS = 70385664, OFF_AVS = 74579968, OFF_BKS = 78774272, OFF_BVS = 79036416;
constexpr size_t MiB = 1u << 20;
constexpr size_t WS_XB = 0, WS_O = 0, WS_W1T = 130 * MiB, WS_W2T = 156 * MiB, WS_Z = 164 * MiB, WS_VT = WS_Z + 357826560,
                 WS_CAK = WS_VT + 85196800, WS_CAVT = WS_CAK + 8 * MiB, WS_CBK = WS_CAVT + 8 * MiB, WS_CBVT = WS_CBK + MiB / 2,
                 WS_RS = WS_CBVT + MiB / 2, WS_PSS = WS_RS + MiB, WS_XS = WS_PSS + 5 * MiB, WS_TAB = WS_XS + 4 * MiB, WS_SINK = WS_TAB + 32768, WS_GF = WS_SINK + 4096, WS_PS = WS_GF + 8192, WS_BAR = WS_PS + 32 * MiB, WS_END = WS_BAR + 16384;
constexpr int MISC_OFF = 159744, LDS_BYTES = 159744 + 64;

struct Params { const float* in[12]; float* out; unsigned char* ws; int ph_lo, ph_hi; };

__device__ __forceinline__ unsigned cvt_pk(float lo, float hi) {
    typedef float f2 __attribute__((ext_vector_type(2))); typedef __bf16 b2 __attribute__((ext_vector_type(2)));
    f2 v = {lo, hi}; b2 b = __builtin_convertvector(v, b2); return __builtin_bit_cast(unsigned, b);
}
__device__ __forceinline__ float bf2f(unsigned short b) { return __uint_as_float((unsigned)b << 16); }
__device__ __forceinline__ float wave_sum(float v) {
#pragma unroll
    for (int o = 1; o < 64; o <<= 1) v += __shfl_xor(v, o);
    return v;
}
#define LDS_WAIT() asm volatile("s_waitcnt lgkmcnt(0)" ::: "memory")
typedef const __attribute__((address_space(4))) Params* kparams_t;
__device__ __forceinline__ kparams_t fresh_params() { kparams_t kp = (kparams_t)__builtin_amdgcn_kernarg_segment_ptr(); asm volatile("" : "+s"(kp)); return kp; }

#define XB_TMO      128
#define XB_XCNT(j)  (256  + 64 * (j))
#define XB_XSUB(j)  (1280 + 64 * (j))
#define XB_XGEN(j)  (2304 + 64 * (j))
#define XB_TOP      3328
#define XB_TOPGEN   3392
#define XCD_BAR_WORDS 3456
#define XB_SPIN_CAP (1u << 18)

__device__ __forceinline__ unsigned xb_ld(unsigned* p)              { return __hip_atomic_load(p, __ATOMIC_RELAXED, __HIP_MEMORY_SCOPE_AGENT); }
__device__ __forceinline__ unsigned xb_add(unsigned* p, unsigned v) { return __hip_atomic_fetch_add(p, v, __ATOMIC_RELAXED, __HIP_MEMORY_SCOPE_AGENT); }
__device__ __forceinline__ unsigned xb_xcc_id() { return (unsigned)__builtin_amdgcn_s_getreg((3 << 11) | 20) & 0xFu; }
#define XB_SPIN(cond, bar) do { unsigned _sp = 0; while (cond) { __builtin_amdgcn_s_sleep(1); \
    if ((++_sp & 255u) == 0u) { if (xb_ld(&(bar)[XB_TMO])) break; if (_sp > XB_SPIN_CAP) { atomicAdd(&(bar)[XB_TMO], 1u); break; } } } } while (0)

struct XcdBarrier {
    unsigned* bar; unsigned x;
    volatile LAS unsigned* st;
};

__device__ __forceinline__ XcdBarrier xcd_barrier_post(unsigned* bar, volatile LAS unsigned* st) {
    XcdBarrier b; b.bar = bar; b.x = xb_xcc_id(); b.st = st;
    if (threadIdx.x == 0) (void)xb_add(&bar[XB_XCNT(b.x)], 1u);
    return b;
}
__device__ __forceinline__ void xcd_barrier_complete(unsigned* bar, unsigned x, unsigned& nloc, unsigned& nx) {
    const unsigned G = gridDim.x * gridDim.y * gridDim.z;
    unsigned sum, cnt, mine, sp = 0u;
    for (;;) {
        sum = 0u; cnt = 0u; mine = 0u;
#pragma unroll
        for (unsigned j = 0; j < 16; ++j) { const unsigned c = xb_ld(&bar[XB_XCNT(j)]); sum += c; cnt += (c > 0u) ? 1u : 0u; mine = (j == x) ? c : mine; }
        if (sum == G) break;
        __builtin_amdgcn_s_sleep(1);
        if ((++sp & 255u) == 0u) { if (xb_ld(&bar[XB_TMO])) break; if (sp > XB_SPIN_CAP) { atomicAdd(&bar[XB_TMO], 1u); break; } }
    }
    nloc = mine > 0u ? mine : 1u; nx = cnt > 0u ? cnt : 1u;
}

__device__ __forceinline__ void xcd_barrier(const XcdBarrier& b) {
    asm volatile("s_waitcnt vmcnt(0)" ::: "memory");
    __syncthreads();
    if (threadIdx.x == 0) {
        unsigned* bar = b.bar;
        __builtin_amdgcn_s_waitcnt(0);
        unsigned nloc = b.st[0], nx = b.st[1];
        if (nloc == 0u) { xcd_barrier_complete(bar, b.x, nloc, nx); b.st[0] = nloc; b.st[1] = nx; }
        const unsigned old = xb_add(&bar[XB_XSUB(b.x)], 1u);
        const unsigned gen = old / nloc;
        if (old + 1u == (gen + 1u) * nloc) {
            __builtin_amdgcn_fence(__ATOMIC_RELEASE, "agent");
            asm volatile("s_waitcnt vmcnt(0)" ::: "memory");
            const unsigned og = xb_add(&bar[XB_TOP], 1u);
            const unsigned tg = og / nx;
            if (og + 1u == (tg + 1u) * nx) xb_add(&bar[XB_TOPGEN], 1u);
            else XB_SPIN(xb_ld(&bar[XB_TOPGEN]) == tg, bar);
            __builtin_amdgcn_fence(__ATOMIC_ACQUIRE, "agent");
            xb_add(&bar[XB_XGEN(b.x)], 1u);
            asm volatile("s_waitcnt vmcnt(0)" ::: "memory");
        } else {
            XB_SPIN(xb_ld(&bar[XB_XGEN(b.x)]) == gen, bar);
            __builtin_amdgcn_fence(__ATOMIC_ACQUIRE, "agent");
            asm volatile("s_waitcnt vmcnt(0)" ::: "memory");
        }
    }
    __syncthreads();
}


namespace pg8 {
#define PG8_LAS __attribute__((address_space(3)))
typedef unsigned short bf16_t;
typedef short bf16x8 __attribute__((ext_vector_type(8)));
typedef float f32x4 __attribute__((ext_vector_type(4)));
typedef unsigned u32x4 __attribute__((ext_vector_type(4)));
constexpr int BM = 256, BK = 64, HALF = 128, HTB = HALF * BK * 2  , STAGE_BYTES = 8 * HTB, NXCD = 8, WGM = 8;

__host__ __device__ __forceinline__ int lds_byte(int r, int c) { const int st = (r >> 4) * 2 + (c >> 5), rr = r & 15, cc = c & 31, ob = rr * 64 + cc * 2; return st * 1024 + (ob ^ (((ob >> 9) & 1) << 5)); }
__host__ __device__ __forceinline__ void stage_rc(int b, int& R, int& C) { const int st = b / 1024, sb = b % 1024, swz = sb ^ (((sb >> 9) & 1) << 5); R = (st >> 1) * 16 + swz / 64; C = (st & 1) * 32 + (swz % 64) / 2; }
__host__ __device__ __forceinline__ int perm32(int rho) { const int n = rho >> 4, i = rho & 15; return 8 * (i >> 2) + 4 * n + (i & 3); }

struct Unit { int pm, pn, ko; };
struct Gemm { const bf16_t* A; const bf16_t* Bt; int M, N, K, ld; };

struct StaticOrder {
    int nM, nN, nwg, G, c;
    __host__ __device__ __forceinline__ void init(int M, int N, int G_, int c_) { nM = M / BM; nN = N / BM; nwg = nM * nN; G = G_; c = c_; }
    __host__ __device__ __forceinline__ bool next(int i, Unit& u) const {
        const long L = (long)i * G + c; if (L >= nwg) return false;
        int wgid = (int)L; { const int q = nwg / NXCD, r = nwg % NXCD, xcd = wgid % NXCD, off = wgid / NXCD; wgid = (xcd < r ? xcd * (q + 1) : r * (q + 1) + (xcd - r) * q) + off; }
        const int nig = WGM * nN, gid = wgid / nig, fm = gid * WGM, gsz = (nM - fm) < WGM ? (nM - fm) : WGM;
        u.pm = fm + ((wgid % nig) % gsz); u.pn = (wgid % nig) / gsz; u.ko = 0; return true;
    }
    __device__ __forceinline__ void a_ready(const Unit&) const {}
    __device__ __forceinline__ void done(const Unit&) const {}
};

}
namespace pg8 {
struct EpiZ {
    static constexpr bool PERM = true, AFTER_DRAIN = false;
    bf16_t* Z; const float* rs; float* out;
    __device__ __forceinline__ void operator()(const f32x4 (&acc)[2][2][4][2], const Unit& u, int wr, int wc, int fr, int fq) const {
        const int row0 = u.pm * BM + wr * 64 + fr;
        const int col0 = u.pn * BM + wc * 32 + 8 * fq;
        const bool isKa = (u.pn >= 4 && u.pn < 8), isKb = (u.pn == 16);
        const bool ctile = (isKa || isKb) && (u.pm >= 128 || (u.pm & 63) >= 62);
#pragma unroll
        for (int ai = 0; ai < 2; ++ai)
#pragma unroll
            for (int m = 0; m < 4; ++m) {
                const int r = row0 + ai * HALF + m * 16;
#pragma unroll
                for (int bj = 0; bj < 2; ++bj) {
                    const f32x4 v0 = acc[ai][bj][m][0], v1 = acc[ai][bj][m][1];
                    u32x4 w; w.x = cvt_pk(v0[0], v0[1]); w.y = cvt_pk(v0[2], v0[3]); w.z = cvt_pk(v1[0], v1[1]); w.w = cvt_pk(v1[2], v1[3]);
                    { const int cc = col0 + bj * HALF; *(u32x4*)(Z + ((size_t)(cc >> 6) * NTOK + r) * 64 + (cc & 63)) = w; }
                    if (ctile) {
                        float* dst = nullptr; const int c = col0 + bj * HALF;
                        if (r >= NTOKP) { const int sidx = r - NTOKP, b = sidx >> 6, i = sidx & 63;
                            dst = isKa ? out + OFF_AKS + ((size_t)(b * 512 + 448 + i) * 1024 + (c - 1024)) : out + OFF_BKS + ((size_t)(b * 128 + 64 + i) * 256 + (c - 4096)); }
                        else { const int b = r >> 14, t = r & 16383;
                            if (isKa) { if (t >= 15872) dst = out + OFF_AKP + ((size_t)(b * 512 + t - 15872) * 1024 + (c - 1024)); }
                            else      { if (t >= 16256) dst = out + OFF_BKP + ((size_t)(b * 128 + t - 16256) * 256 + (c - 4096)); } }
                        if (dst) { *(f32x4*)dst = v0; *(f32x4*)(dst + 4) = v1; }
                    }
                }
            }
    }
};
struct EpiVt {
    static constexpr bool PERM = true, AFTER_DRAIN = false;
    bf16_t* VT; const float* rs; float* out;
    __device__ __forceinline__ void operator()(const f32x4 (&acc)[2][2][4][2], const Unit& u, int wr, int wc, int fr, int fq) const {
        const int row0 = u.pm * BM + wr * 64 + fr;
        const int tok0 = u.pn * BM + wc * 32 + 8 * fq;
        const bool ctile = (u.pn >= 128 || (u.pn & 63) >= 62);
#pragma unroll
        for (int ai = 0; ai < 2; ++ai)
#pragma unroll
            for (int m = 0; m < 4; ++m) {
                const int r = row0 + ai * HALF + m * 16;
#pragma unroll
                for (int bj = 0; bj < 2; ++bj) {
                    const f32x4 v0 = acc[ai][bj][m][0], v1 = acc[ai][bj][m][1];
                    u32x4 w; w.x = cvt_pk(v0[0], v0[1]); w.y = cvt_pk(v0[2], v0[3]); w.z = cvt_pk(v1[0], v1[1]); w.w = cvt_pk(v1[2], v1[3]);
                    { const int tk0 = tok0 + bj * HALF; *(u32x4*)(VT + ((size_t)(tk0 >> 6) * NVC + r) * 64 + (tk0 & 63)) = w; }
                    if (ctile) {
#pragma unroll
                        for (int e = 0; e < 8; ++e) {
                            const int tk = tok0 + bj * HALF + e; const float val = e < 4 ? v0[e & 3] : v1[e & 3];
                            if (tk >= NTOKP) { const int sidx = tk - NTOKP, b = sidx >> 6, i = sidx & 63;
                                if (r < 1024) out[OFF_AVS + (size_t)(b * 512 + 448 + i) * 1024 + r] = val;
                                else          out[OFF_BVS + (size_t)(b * 128 + 64 + i) * 256 + (r - 1024)] = val; }
                            else { const int b = tk >> 14, t = tk & 16383;
                                if (r < 1024) { if (t >= 15872) out[OFF_AVP + (size_t)(b * 512 + t - 15872) * 1024 + r] = val; }
                                else          { if (t >= 16256) out[OFF_BVP + (size_t)(b * 128 + t - 16256) * 256 + (r - 1024)] = val; } }
                        }
                    }
                }
            }
    }
};
struct SplitK8 {
    int G, c;
    __device__ __forceinline__ bool next(int i, Unit& u) const { const int L = i * G + c; if (L >= 128) return false; const int t = L >> 3; u.pm = 128 + (t >> 3); u.pn = t & 7; u.ko = 256 * (L & 7); return true; }
    __device__ __forceinline__ void a_ready(const Unit&) const {}
    __device__ __forceinline__ void done(const Unit&) const {}
};
struct EpiYS {
    static constexpr bool PERM = false, AFTER_DRAIN = false;
    float* YS;
    __device__ __forceinline__ void operator()(const f32x4 (&acc)[2][2][4][2], const Unit& u, int wr, int wc, int fr, int fq) const {
        const int col0 = u.pn * BM + wc * 32 + 4 * fq;
#pragma unroll
        for (int ai = 0; ai < 2; ++ai)
#pragma unroll
            for (int m = 0; m < 4; ++m) {
                float* yrow = YS + ((size_t)(u.ko >> 8) * 512 + (u.pm - 128) * BM + ai * HALF + wr * 64 + m * 16 + fr) * DM + col0;
#pragma unroll
                for (int bj = 0; bj < 2; ++bj)
#pragma unroll
                    for (int n = 0; n < 2; ++n) *(f32x4*)(yrow + bj * HALF + n * 16) = acc[ai][bj][m][n];
            }
    }
};
struct EpiY {
    static constexpr bool PERM = true, AFTER_DRAIN = false;
    const float* xp; const float* xs; bf16_t* YB; float* pss;
    __device__ __forceinline__ const float* xrow(int r) const { return (r < NTOKP) ? xp + (size_t)r * DM : xs + (size_t)(r - NTOKP) * DM; }
    __device__ __forceinline__ void operator()(const f32x4 (&acc)[2][2][4][2], const Unit& u, int wr, int wc, int fr, int fq) const {
        const int col0 = u.pn * BM + wc * 32 + 8 * fq;
        const int rbase = u.pm * BM + wr * 64 + fr;
        f32x4 xv[2][2];
        { const float* xr = xrow(rbase) + col0; xv[0][0] = __builtin_nontemporal_load((const f32x4*)(xr)); xv[0][1] = __builtin_nontemporal_load((const f32x4*)(xr + 4)); }
        float q = 0.f;
#pragma unroll
        for (int s2 = 0; s2 < 16; ++s2) {
            const int g = s2 >> 1, bj = s2 & 1, ai = g >> 2, m = g & 3, cb = s2 & 1;
            if (s2 + 1 < 16) { const int g1 = (s2 + 1) >> 1, bj1 = (s2 + 1) & 1; const int r1 = rbase + (g1 >> 2) * HALF + (g1 & 3) * 16; const float* xr = xrow(r1) + col0 + bj1 * HALF;
                xv[cb ^ 1][0] = __builtin_nontemporal_load((const f32x4*)(xr)); xv[cb ^ 1][1] = __builtin_nontemporal_load((const f32x4*)(xr + 4)); }
            const int r = rbase + ai * HALF + m * 16;
            const f32x4 y0 = xv[cb][0] + acc[ai][bj][m][0], y1 = xv[cb][1] + acc[ai][bj][m][1];
            u32x4 w; w.x = cvt_pk(y0[0], y0[1]); w.y = cvt_pk(y0[2], y0[3]); w.z = cvt_pk(y1[0], y1[1]); w.w = cvt_pk(y1[2], y1[3]);
            *(u32x4*)(YB + (size_t)r * DM + col0 + bj * HALF) = w;
            q += (y0[0] * y0[0] + y0[1] * y0[1]) + (y0[2] * y0[2] + y0[3] * y0[3]) + (y1[0] * y1[0] + y1[1] * y1[1]) + (y1[2] * y1[2] + y1[3] * y1[3]);
            if (bj == 1) { q += __shfl_xor(q, 16); q += __shfl_xor(q, 32); if (fq == 0) pss[(size_t)r * 32 + u.pn * 4 + wc] = q; q = 0.f; }
        }
    }
};
}

namespace pg8 {
template <class Epi, class Sched, bool ALIGN_EPI = false, bool SP2 = false>
__device__ __forceinline__ void gemm_phase(PG8_LAS unsigned char* lds, const Gemm g, const Sched& S, const Epi& E) {
    int tid_ = threadIdx.x; asm volatile("" : "+v"(tid_)); const int tid = tid_, wid = __builtin_amdgcn_readfirstlane(tid >> 6), lane = tid & 63, wr = wid >> 2, wc = wid & 3, fr = lane & 15, fq = lane >> 4;
    const int K = g.K, nt = K / BK, LD = g.ld;
    unsigned voffA[2], voffB[2];
#pragma unroll
    for (int i = 0; i < 2; ++i) { int R, C; stage_rc(tid * 16 + i * 8192, R, C); const int Rb = Epi::PERM ? ((R & ~31) + perm32(R & 31)) : R;
        voffA[i] = (unsigned)(R * LD + C) * 2u; voffB[i] = (unsigned)(Rb * LD + C) * 2u; }
    const size_t kstep = (size_t)(BK * 2);
    const size_t hstep = (size_t)HALF * LD * 2;
    const size_t tstep = 2 * hstep;
    const unsigned ldsw = (unsigned)wid * 1024u;
    const int aoff = lds_byte(wr * 64 + fr, fq * 8), boff = lds_byte(wc * 32 + fr, fq * 8);
#define PG8_SA(b, h) (((b) * 2 + (h)) * HTB)
#define PG8_SB(b, h) ((4 + (b) * 2 + (h)) * HTB)
#define PG8_STAGE(bufoff, gbase, voff) do { _Pragma("unroll") for (int _i = 0; _i < 2; ++_i) \
        __builtin_amdgcn_global_load_lds((const unsigned*)((const char*)(gbase) + (voff)[_i]), (PG8_LAS unsigned*)(lds + (bufoff) + ldsw + _i * 8192), 16, 0, 0); } while (0)
#define PG8_LDA(dst, b, h) do { _Pragma("unroll") for (int m = 0; m < 4; ++m) _Pragma("unroll") for (int k = 0; k < 2; ++k) dst[m][k] = *(const PG8_LAS bf16x8*)(lds + PG8_SA(b, h) + aoff + m * 2048 + k * 1024); } while (0)
#define PG8_LDB(dst, b, h) do { _Pragma("unroll") for (int n = 0; n < 2; ++n) _Pragma("unroll") for (int k = 0; k < 2; ++k) dst[n][k] = *(const PG8_LAS bf16x8*)(lds + PG8_SB(b, h) + boff + n * 2048 + k * 1024); } while (0)
#define PG8_MMA(ai, bj, At, Bt) do { __builtin_amdgcn_s_setprio(1); _Pragma("unroll") for (int m = 0; m < 4; ++m) _Pragma("unroll") for (int n = 0; n < 2; ++n) _Pragma("unroll") for (int k = 0; k < 2; ++k) \
        acc[ai][bj][m][n] = __builtin_amdgcn_mfma_f32_16x16x32_bf16(Bt[n][k], At[m][k], acc[ai][bj][m][n], 0, 0, 0); __builtin_amdgcn_s_setprio(0); } while (0)
#define PG8_WAIT_V(n) asm volatile("s_waitcnt vmcnt(" #n ")" ::: "memory")
#define PG8_WAIT_L(n) asm volatile("s_waitcnt lgkmcnt(" #n ")" ::: "memory")
#define PG8_BAR __builtin_amdgcn_s_barrier()
#define PG8_SCHED __builtin_amdgcn_sched_barrier(0)
    Unit cur, nxt; int ui = 0;
    if (!S.next(0, cur)) return;
    f32x4 acc[2][2][4][2];
#pragma unroll
    for (int a = 0; a < 2; ++a)
#pragma unroll
        for (int b = 0; b < 2; ++b)
#pragma unroll
            for (int m = 0; m < 4; ++m)
#pragma unroll
                for (int n = 0; n < 2; ++n) acc[a][b][m][n] = (f32x4){0.f, 0.f, 0.f, 0.f};
    bf16x8 At[4][2], B0[2][2], B1[2][2];
    const char* cA = (const char*)g.A + (size_t)cur.pm * tstep + (size_t)cur.ko * 2; const char* cB = (const char*)g.Bt + (size_t)cur.pn * tstep + (size_t)cur.ko * 2;
    S.a_ready(cur);
    if constexpr (SP2) {
        PG8_STAGE(PG8_SB(0, 0), cB, voffB); PG8_STAGE(PG8_SB(0, 1), cB + hstep, voffB); PG8_STAGE(PG8_SA(0, 0), cA, voffA); PG8_STAGE(PG8_SA(0, 1), cA + hstep, voffA);
        if (wr == 1) PG8_BAR;
        PG8_WAIT_V(2); PG8_BAR;
        PG8_STAGE(PG8_SB(1, 0), cB + kstep, voffB); PG8_STAGE(PG8_SA(1, 0), cA + kstep, voffA); PG8_STAGE(PG8_SB(1, 1), cB + hstep + kstep, voffB);
        PG8_WAIT_V(6); PG8_BAR;
    } else {
        PG8_STAGE(PG8_SB(0, 0), cB, voffB); PG8_STAGE(PG8_SA(0, 0), cA, voffA); PG8_STAGE(PG8_SB(0, 1), cB + hstep, voffB); PG8_STAGE(PG8_SA(0, 1), cA + hstep, voffA);
        if (wr == 1) PG8_BAR;
        PG8_WAIT_V(4); PG8_BAR;
        PG8_STAGE(PG8_SB(1, 0), cB + kstep, voffB); PG8_STAGE(PG8_SA(1, 0), cA + kstep, voffA); PG8_STAGE(PG8_SB(1, 1), cB + hstep + kstep, voffB);
        PG8_WAIT_V(6); PG8_BAR;
    }
    for (;;) {
        const bool has_next = S.next(ui + 1, nxt);
        const char* nA = has_next ? (const char*)g.A + (size_t)nxt.pm * tstep + (size_t)nxt.ko * 2 : cA; const char* nB = has_next ? (const char*)g.Bt + (size_t)nxt.pn * tstep + (size_t)nxt.ko * 2 : cB;
        for (int t = 0; t < nt; t += 2) {
            const bool last = (t == nt - 2);
            const char* a1 = cA + (size_t)(t + 1) * kstep;
            const char* a2 = last ? nA : cA + (size_t)(t + 2) * kstep; const char* b2 = last ? nB : cB + (size_t)(t + 2) * kstep;
            const char* a3 = a2 + kstep; const char* b3 = b2 + kstep;
            if (last && has_next) S.a_ready(nxt);
            if constexpr (SP2) {
            PG8_LDB(B0, 0, 0); PG8_LDB(B1, 0, 1); PG8_SCHED; PG8_LDA(At, 0, 0); PG8_STAGE(PG8_SA(1, 1), a1 + hstep, voffA);
            PG8_WAIT_V(8); PG8_WAIT_L(0); PG8_BAR; PG8_MMA(0, 0, At, B0); PG8_MMA(0, 1, At, B1); PG8_BAR; PG8_SCHED;
            PG8_LDA(At, 0, 1); PG8_STAGE(PG8_SB(0, 0), b2, voffB); PG8_STAGE(PG8_SB(0, 1), b2 + hstep, voffB); PG8_STAGE(PG8_SA(0, 0), a2, voffA);
            PG8_WAIT_V(8); PG8_WAIT_L(0); PG8_BAR; PG8_MMA(1, 0, At, B0); PG8_MMA(1, 1, At, B1); PG8_BAR; PG8_SCHED;
            PG8_LDB(B0, 1, 0); PG8_LDB(B1, 1, 1); PG8_SCHED; PG8_LDA(At, 1, 0); PG8_STAGE(PG8_SA(0, 1), a2 + hstep, voffA);
            PG8_WAIT_V(8); PG8_WAIT_L(0); PG8_BAR; PG8_MMA(0, 0, At, B0); PG8_MMA(0, 1, At, B1); PG8_BAR; PG8_SCHED;
            PG8_LDA(At, 1, 1); PG8_STAGE(PG8_SB(1, 0), b3, voffB); PG8_STAGE(PG8_SB(1, 1), b3 + hstep, voffB); PG8_STAGE(PG8_SA(1, 0), a3, voffA);
            PG8_WAIT_V(8); PG8_WAIT_L(0); PG8_BAR; PG8_MMA(1, 0, At, B0); PG8_MMA(1, 1, At, B1); PG8_BAR; PG8_SCHED;
            } else {
            PG8_LDB(B0, 0, 0); PG8_SCHED; PG8_LDA(At, 0, 0); PG8_STAGE(PG8_SA(1, 1), a1 + hstep, voffA);
            PG8_WAIT_L(8); PG8_BAR; PG8_WAIT_L(0); PG8_MMA(0, 0, At, B0); PG8_BAR; PG8_SCHED;
            PG8_LDB(B1, 0, 1); PG8_STAGE(PG8_SB(0, 0), b2, voffB);
            PG8_BAR; PG8_WAIT_L(0); PG8_MMA(0, 1, At, B1); PG8_BAR;
            PG8_LDA(At, 0, 1); PG8_STAGE(PG8_SA(0, 0), a2, voffA);
            PG8_BAR; PG8_WAIT_L(0); PG8_MMA(1, 0, At, B0); PG8_BAR; PG8_SCHED;
            PG8_STAGE(PG8_SB(0, 1), b2 + hstep, voffB);
            PG8_WAIT_V(6); PG8_BAR; PG8_MMA(1, 1, At, B1); PG8_BAR;
            PG8_LDB(B0, 1, 0); PG8_SCHED; PG8_LDA(At, 1, 0); PG8_STAGE(PG8_SA(0, 1), a2 + hstep, voffA);
            PG8_WAIT_L(8); PG8_BAR; PG8_WAIT_L(0); PG8_MMA(0, 0, At, B0); PG8_BAR; PG8_SCHED;
            PG8_LDB(B1, 1, 1); PG8_STAGE(PG8_SB(1, 0), b3, voffB);
            PG8_BAR; PG8_WAIT_L(0); PG8_MMA(0, 1, At, B1); PG8_BAR;
            PG8_LDA(At, 1, 1); PG8_STAGE(PG8_SA(1, 0), a3, voffA);
            PG8_BAR; PG8_WAIT_L(0); PG8_MMA(1, 0, At, B0); PG8_BAR; PG8_SCHED;
            PG8_STAGE(PG8_SB(1, 1), b3 + hstep, voffB);
            PG8_WAIT_V(6); PG8_BAR; PG8_MMA(1, 1, At, B1); PG8_BAR;
            }
        }
        if constexpr (ALIGN_EPI) { if (wr == 0) PG8_BAR; }
        if constexpr (!Epi::AFTER_DRAIN) { E(acc, cur, wr, wc, fr, fq); S.done(cur); }
        if (!has_next) break;
#pragma unroll
        for (int a = 0; a < 2; ++a)
#pragma unroll
            for (int b = 0; b < 2; ++b)
#pragma unroll
                for (int m = 0; m < 4; ++m)
#pragma unroll
                    for (int n = 0; n < 2; ++n) acc[a][b][m][n] = (f32x4){0.f, 0.f, 0.f, 0.f};
        cur = nxt; cA = nA; cB = nB; ++ui;
        if constexpr (ALIGN_EPI) { if (wr == 1) PG8_BAR; }
    }
    PG8_WAIT_V(0);
    if constexpr (!ALIGN_EPI) { if (wr == 0) PG8_BAR; }
    PG8_BAR;
    if constexpr (Epi::AFTER_DRAIN) { E.fused(acc, cur, wr, wc, fr, fq, lds, wid, lane); S.done(cur); }
#undef PG8_SA
#undef PG8_SB
#undef PG8_STAGE
#undef PG8_LDA
#undef PG8_LDB
#undef PG8_MMA
#undef PG8_WAIT_V
#undef PG8_WAIT_L
#undef PG8_BAR
#undef PG8_SCHED
}
}
__device__ __forceinline__ void transpose_item(const float* __restrict__ W, int N, bf16_t* __restrict__ WT, int ldt, LAS float* scr, int k0, int n0, int dest_row0,
                                               const float* __restrict__ gain, float mul, int lane) {
    f32x4 v[8];
#pragma unroll
    for (int i = 0; i < 8; ++i) { const int pp = lane + 64 * i, kk = pp >> 3, c4 = pp & 7; v[i] = __builtin_nontemporal_load((const f32x4*)(W + (size_t)(k0 + kk) * N + n0 + 4 * c4)); }
#pragma unroll
    for (int i = 0; i < 8; ++i) { const int pp = lane + 64 * i, kk = pp >> 3, c4 = pp & 7; const float g = gain ? gain[k0 + kk] * mul : mul;
        LAS float* d = scr + kk * 33 + 4 * c4; d[0] = v[i][0] * g; d[1] = v[i][1] * g; d[2] = v[i][2] * g; d[3] = v[i][3] * g; }
    LDS_WAIT(); asm volatile("" ::: "memory");
    const int c = lane & 7;
#pragma unroll
    for (int j = 0; j < 4; ++j) { const int n = (lane >> 3) + 8 * j; const LAS float* s = scr + (8 * c) * 33 + n;
        u32x4 o; o.x = cvt_pk(s[0 * 33], s[1 * 33]); o.y = cvt_pk(s[2 * 33], s[3 * 33]); o.z = cvt_pk(s[4 * 33], s[5 * 33]); o.w = cvt_pk(s[6 * 33], s[7 * 33]);
        *(u32x4*)(WT + (size_t)(dest_row0 + n) * ldt + k0 + 8 * c) = o; }
    LDS_WAIT(); asm volatile("" ::: "memory");
}
__device__ __forceinline__ int permcol(int n) {
    if (n < 2048) return n;
    if (n < 3072) return 5376 + (n - 2048);
    if (n < 4096) return 2048 + (n - 3072);
    if (n < 5120) return 3072 + (n - 4096);
    if (n < 5376) return 4096 + (n - 5120);
    if (n < 5632) return 6400 + (n - 5376);
    return 4352 + (n - 5632);
}
__device__ __forceinline__ void cache_copy(const float* __restrict__ src, float* __restrict__ dstf, bf16_t* __restrict__ dstb, int rows, int rowlen, int gtid, int gthreads) {
    const int per_b = rows * rowlen, n4 = 8 * per_b / 4;
    for (int i4 = gtid; i4 < n4; i4 += gthreads) {
        const int e = i4 * 4, b = e / per_b, rem = e - b * per_b, r = rem / rowlen;
        const f32x4 v = __builtin_nontemporal_load((const f32x4*)(src + e));
        if (dstb) { u32x2 w; w.x = cvt_pk(v[0], v[1]); w.y = cvt_pk(v[2], v[3]); *(u32x2*)(dstb + e) = w; }
        if (r >= 64) __builtin_nontemporal_store(v, (f32x4*)(dstf + (size_t)b * per_b + rem - 64 * rowlen));
    }
}
__device__ __forceinline__ void phase0(const Params& p, LAS unsigned char* lds) {
    int tid_ = threadIdx.x; asm volatile("" : "+v"(tid_));
    const int tid = tid_, lane = tid & 63, wave = __builtin_amdgcn_readfirstlane(tid >> 6);
    LAS float* scr = (LAS float*)(lds + wave * 16384);
    const int gw = blockIdx.x * 8 + wave, NGW = gridDim.x * 8;
    unsigned char* ws = p.ws;
    bf16_t* W1T = (bf16_t*)(ws + WS_W1T); bf16_t* W2T = (bf16_t*)(ws + WS_W2T);
    constexpr int I_W1 = 32 * 208, I_W2 = 32 * 64;
    if (wave < 3) for (int it = blockIdx.x * 3 + wave; it < I_W1 + I_W2; it += gridDim.x * 3) {
        int r = it;
        if (r < I_W1) { const int kb = r / 208, nb = r % 208, n0 = nb * 32; const bool isq = (n0 < 1024) || (n0 >= 4096 && n0 < 5120);
            transpose_item(p.in[7], 6656, W1T, 2048, scr, kb * 64, n0, permcol(n0), p.in[6], isq ? C2 : 1.0f, lane); continue; }
        r -= I_W1;
        { const int kb = r / 64, nb = r % 64; transpose_item(p.in[10], 2048, W2T, 2048, scr, kb * 64, nb * 32, nb * 32, nullptr, 1.0f, lane); }
    }
    bf16_t* XB = (bf16_t*)(ws + WS_XB);
    if (wave >= 3) for (int m = blockIdx.x * 5 + (wave - 3); m < NTOK; m += gridDim.x * 5) {
        const float* xrow = (m < NTOKP) ? p.in[0] + (size_t)m * DM : p.in[1] + (size_t)(m - NTOKP) * DM;
        const f32x4* xr = (const f32x4*)xrow + lane;
        f32x4 v[8]; float s = 0.f;
#pragma unroll
        for (int j = 0; j < 8; ++j) { v[j] = __builtin_nontemporal_load(&xr[64 * j]); s += (v[j][0] * v[j][0] + v[j][1] * v[j][1]) + (v[j][2] * v[j][2] + v[j][3] * v[j][3]); }
        s = wave_sum(s);
        const float rr = 1.0f / sqrtf(s * (1.0f / DM) + RMS_EPS);
        u32x2* o8 = (u32x2*)(XB + (size_t)m * DM) + lane;
#pragma unroll
        for (int j = 0; j < 8; ++j) { u32x2 w; w.x = cvt_pk(v[j][0] * rr, v[j][1] * rr); w.y = cvt_pk(v[j][2] * rr, v[j][3] * rr); o8[64 * j] = w; }
    }
    const int gtid = blockIdx.x * 512 + tid, gthreads = gridDim.x * 512;
    for (int i = gtid; i < 16 * 320; i += gthreads) ((float*)(ws + WS_TAB))[i] = p.in[8][i] * LOG2E;
    if (gtid < 16) ((float*)(ws + WS_SINK))[gtid] = p.in[9][gtid] * LOG2E;
    for (int i = gtid; i < DM; i += gthreads) ((float*)(ws + WS_GF))[i] = p.in[11][i];
    for (int i = gtid; i < 512 * DM / 4; i += gthreads) ((f32x4*)(ws + WS_XS))[i] = ((const f32x4*)p.in[1])[i];
}

__device__ __forceinline__ void cache_phase(LAS unsigned char* lds, int w, int nw) {
    int tid_ = threadIdx.x; asm volatile("" : "+v"(tid_));
    const int tid = tid_, lane = tid & 63, wave = __builtin_amdgcn_readfirstlane(tid >> 6);
    kparams_t kp = fresh_params(); unsigned char* ws = kp->ws; float* out = kp->out;
    const float* cak = kp->in[2]; const float* cav = kp->in[3]; const float* cbk = kp->in[4]; const float* cbv = kp->in[5];
    LAS float* scr = (LAS float*)(lds + wave * 16384);
    constexpr int I_CAV = 8 * 8 * 32, I_CBV = 8 * 2 * 8;
    for (int r = w * 8 + wave; r < I_CAV + I_CBV; r += nw * 8) {
        if (r < I_CAV) { const int b = r >> 8, q = r & 255, kb = q >> 5, nb = q & 31;
            transpose_item(cav + (size_t)b * 512 * 1024, 1024, (bf16_t*)(ws + WS_CAVT) + (size_t)b * 1024 * 512, 512, scr, kb * 64, nb * 32, nb * 32, nullptr, 1.0f, lane); }
        else { const int r2 = r - I_CAV, b = r2 >> 4, q = r2 & 15, kb = q >> 3, nb = q & 7;
            transpose_item(cbv + (size_t)b * 128 * 256, 256, (bf16_t*)(ws + WS_CBVT) + (size_t)b * 256 * 128, 128, scr, kb * 64, nb * 32, nb * 32, nullptr, 1.0f, lane); }
    }
    const int gtid = w * 512 + tid, gthreads = nw * 512;
    cache_copy(cak, out + OFF_AKS, (bf16_t*)(ws + WS_CAK), 512, 1024, gtid, gthreads);
    cache_copy(cav, out + OFF_AVS, nullptr, 512, 1024, gtid, gthreads);
    cache_copy(cbk, out + OFF_BKS, (bf16_t*)(ws + WS_CBK), 128, 256, gtid, gthreads);
    cache_copy(cbv, out + OFF_BVS, nullptr, 128, 256, gtid, gthreads);
}

#define MFMA32(a, b, c) __builtin_amdgcn_mfma_f32_32x32x16_bf16((a), (b), (c), 0, 0, 0)
__device__ __forceinline__ float ex2(float x) { return __builtin_amdgcn_exp2f(x); }
constexpr int AT_BUFB = 70656, AT_VROW = 144, AT_TAB = 2 * AT_BUFB;

template <int HG>
__device__ __forceinline__ void at_load(u32x4 (&kr)[HG], u32x4 (&vr)[HG], const bf16_t* __restrict__ Kb, int kstr, size_t khs, const bf16_t* __restrict__ Vb, int vstr, int tid) {
#pragma unroll
    for (int i = 0; i < HG; ++i) { const int pp = tid + 512 * i; const int row = pp / (HG * 8), c16 = pp % (HG * 8);
        kr[i] = *(const u32x4*)(Kb + (size_t)(c16 >> 3) * khs + (size_t)row * kstr + (c16 & 7) * 8); }
#pragma unroll
    for (int i = 0; i < HG; ++i) { const int pp = tid + 512 * i; const int row = pp >> 3, c16 = pp & 7;
        vr[i] = *(const u32x4*)(Vb + (size_t)row * vstr + c16 * 8); }
}
template <int HG>
__device__ __forceinline__ void at_store(const u32x4 (&kr)[HG], const u32x4 (&vr)[HG], LAS unsigned char* buf, int tid) {
    constexpr int RS = HG * 128 + 16, KB = 64 * RS;
#pragma unroll
    for (int i = 0; i < HG; ++i) { const int pp = tid + 512 * i; const int row = pp / (HG * 8), c16 = pp % (HG * 8);
        *(LAS u32x4*)(buf + row * RS + c16 * 16) = kr[i]; }
#pragma unroll
    for (int i = 0; i < HG; ++i) { const int pp = tid + 512 * i; const int row = pp >> 3, c16 = pp & 7;
        LAS unsigned char* d = buf + KB + row * AT_VROW + ((c16 & ~1) * 2 + (c16 & 1)) * 8;
        *(LAS u32x2*)(d) = (u32x2){vr[i].x, vr[i].y}; *(LAS u32x2*)(d + 16) = (u32x2){vr[i].z, vr[i].w}; }
}

constexpr int PR_BUFB = 9216 + 64 * AT_VROW, PR_PAIRB = 2 * PR_BUFB, PR_TAB = 4 * PR_PAIRB;
__device__ __forceinline__ void at_load_p(u32x4 (&kr)[4], u32x4 (&vr)[4], const bf16_t* __restrict__ Kb, int kstr, const bf16_t* __restrict__ Vb, int vstr, int ptid) {
#pragma unroll
    for (int i = 0; i < 4; ++i) { const int pp = ptid + 128 * i, row = pp >> 3, c16 = pp & 7; kr[i] = *(const u32x4*)(Kb + (size_t)row * kstr + c16 * 8); }
#pragma unroll
    for (int i = 0; i < 4; ++i) { const int pp = ptid + 128 * i, row = pp >> 3, c16 = pp & 7; vr[i] = *(const u32x4*)(Vb + (size_t)row * vstr + c16 * 8); }
}
__device__ __forceinline__ void at_store_p(const u32x4 (&kr)[4], const u32x4 (&vr)[4], LAS unsigned char* buf, int ptid) {
#pragma unroll
    for (int i = 0; i < 4; ++i) { const int pp = ptid + 128 * i, row = pp >> 3, c16 = pp & 7; *(LAS u32x4*)(buf + row * 144 + c16 * 16) = kr[i]; }
#pragma unroll
    for (int i = 0; i < 4; ++i) { const int pp = ptid + 128 * i, row = pp >> 3, c16 = pp & 7;
        LAS unsigned char* d = buf + 9216 + row * AT_VROW + ((c16 & ~1) * 2 + (c16 & 1)) * 8;
        *(LAS u32x2*)(d) = (u32x2){vr[i].x, vr[i].y}; *(LAS u32x2*)(d + 16) = (u32x2){vr[i].z, vr[i].w}; }
}
__device__ __forceinline__ void pair_sync(volatile LAS unsigned* cnt, unsigned& ep, int lane) {
    asm volatile("s_waitcnt lgkmcnt(0)" ::: "memory");
    ep += 2u;
    if (lane == 0) __hip_atomic_fetch_add((LAS unsigned*)cnt, 1u, __ATOMIC_RELAXED, __HIP_MEMORY_SCOPE_WORKGROUP);
    while (*cnt < ep) __builtin_amdgcn_s_sleep(1);
    asm volatile("" ::: "memory");
}

template <bool ISA, int HG>
__device__ __forceinline__ void attn_tile(const LAS unsigned char* buf, int hl, const bf16x8 (&q)[4], f32x16& o0, f32x16& o1, float& m, float& l,
                                          int bias_base, bool cbias, float cval, float slope2, const LAS float* tab, int r32, int hi) {
    constexpr int RS = HG * 128 + 16, KB = 64 * RS;
    const LAS unsigned char* kp = buf + r32 * RS + (hl * 64 + 8 * hi) * 2;
    bf16x8 k0[4], k1[4];
#pragma unroll
    for (int d0 = 0; d0 < 4; ++d0) { k0[d0] = *(const LAS bf16x8*)(kp + 32 * d0); k1[d0] = *(const LAS bf16x8*)(kp + 32 * RS + 32 * d0); }
    f32x16 s0, s1;
    if (ISA) {
        if (cbias) {
#pragma unroll
            for (int r = 0; r < 16; ++r) { s0[r] = 0.f; s1[r] = 0.f; }
        } else {
            const LAS float* tb = tab + (383 - bias_base);
#pragma unroll
            for (int r = 0; r < 16; ++r) { const int off = (r & 3) + 8 * (r >> 2); s0[r] = tb[off]; s1[r] = tb[off + 32]; }
        }
    } else {
#pragma unroll
        for (int r = 0; r < 16; ++r) { const int off = (r & 3) + 8 * (r >> 2); const int d = bias_base - off;
            s0[r] = -slope2 * fabsf((float)d); s1[r] = -slope2 * fabsf((float)(d - 32)); }
    }
#pragma unroll
    for (int d0 = 0; d0 < 4; ++d0) { s0 = MFMA32(k0[d0], q[d0], s0); s1 = MFMA32(k1[d0], q[d0], s1); }
    float mx;
    { float m4[4];
#pragma unroll
      for (int k = 0; k < 4; ++k) { m4[k] = fmaxf(fmaxf(s0[k], s1[k]), s0[k + 4]); m4[k] = fmaxf(fmaxf(m4[k], s1[k + 4]), s0[k + 8]); m4[k] = fmaxf(fmaxf(m4[k], s1[k + 8]), s0[k + 12]); m4[k] = fmaxf(m4[k], s1[k + 12]); }
      mx = fmaxf(fmaxf(m4[0], m4[1]), fmaxf(m4[2], m4[3])); }
    { auto rr = __builtin_amdgcn_permlane32_swap(__float_as_uint(mx), __float_as_uint(mx), false, false); mx = fmaxf(__uint_as_float(rr[0]), __uint_as_float(rr[1])); }
    const float csh = (ISA && cbias) ? cval : 0.f;
    mx += csh;
    if (__builtin_amdgcn_ballot_w64(mx > m + 8.0f) != 0ull) {
        const float mn = fmaxf(m, mx), alpha = ex2(m - mn); m = mn; l *= alpha;
#pragma unroll
        for (int r = 0; r < 16; ++r) { o0[r] *= alpha; o1[r] *= alpha; }
    }
    { const float mr = m - csh;
#pragma unroll
      for (int r = 0; r < 16; ++r) { s0[r] = ex2(s0[r] - mr); s1[r] = ex2(s1[r] - mr); } }
    { float a4[4];
#pragma unroll
      for (int k = 0; k < 4; ++k) {
          float t0 = s0[k] + s1[k], t1 = s0[k + 4] + s1[k + 4], t2 = s0[k + 8] + s1[k + 8], t3 = s0[k + 12] + s1[k + 12];
          asm volatile("" : "+v"(t0), "+v"(t1), "+v"(t2), "+v"(t3));
          float u0 = t0 + t1, u1 = t2 + t3; asm volatile("" : "+v"(u0), "+v"(u1));
          a4[k] = u0 + u1; asm volatile("" : "+v"(a4[k])); }
      float w0 = a4[0] + a4[1], w1 = a4[2] + a4[3]; asm volatile("" : "+v"(w0), "+v"(w1));
      l += w0 + w1; }
    bf16x8 pf[4];
#pragma unroll
    for (int ks = 0; ks < 4; ++ks) { u32x4 w;
        if (ks < 2) { const int b = 8 * ks; w.x = cvt_pk(s0[b], s0[b + 1]); w.y = cvt_pk(s0[b + 2], s0[b + 3]); w.z = cvt_pk(s0[b + 4], s0[b + 5]); w.w = cvt_pk(s0[b + 6], s0[b + 7]); }
        else { const int b = 8 * (ks - 2); w.x = cvt_pk(s1[b], s1[b + 1]); w.y = cvt_pk(s1[b + 2], s1[b + 3]); w.z = cvt_pk(s1[b + 4], s1[b + 5]); w.w = cvt_pk(s1[b + 6], s1[b + 7]); }
        pf[ks] = __builtin_bit_cast(bf16x8, w); }
    __builtin_amdgcn_sched_barrier(0);
    const LAS unsigned char* vp0 = buf + KB + (hl * 64 + r32) * AT_VROW + 16 * hi;
    const LAS unsigned char* vp1 = vp0 + 32 * AT_VROW;
    u32x4 va[2][4];
#pragma unroll
    for (int ks = 0; ks < 4; ++ks) { va[0][ks] = *(const LAS u32x4*)(vp0 + 32 * ks); va[1][ks] = *(const LAS u32x4*)(vp1 + 32 * ks); }
    __builtin_amdgcn_sched_barrier(0);
#pragma unroll
    for (int ks = 0; ks < 4; ++ks) {
        o0 = MFMA32(__builtin_bit_cast(bf16x8, va[0][ks]), pf[ks], o0); o1 = MFMA32(__builtin_bit_cast(bf16x8, va[1][ks]), pf[ks], o1); }
}

template <bool ISA, bool PAIR>
__device__ __forceinline__ void attn_stream(unsigned char* ws, int vb, LAS unsigned char* lds, int tid, int lane, int wave) {
    static_assert(ISA || !PAIR, "pair mode is for type A");
    constexpr int HG = PAIR ? 1 : (ISA ? 4 : 1), NP = ISA ? 8 : 2, NKR = PAIR ? 4 : HG;
    const int ptid = tid & 127, pr = wave >> 1;
    LAS unsigned char* const pbase = PAIR ? lds + pr * PR_PAIRB : lds;
    constexpr int BUFB = PAIR ? PR_BUFB : AT_BUFB;
    volatile LAS unsigned* const pcnt = (volatile LAS unsigned*)(lds + MISC_OFF + 16) + pr; unsigned ep = 0u;
    if (PAIR) { __syncthreads(); if (lane == 0 && (wave & 1) == 0) *pcnt = 0u; __syncthreads(); }
#define AT_LOAD(Kb, kstr, khs, Vb, vstr) do { if constexpr (PAIR) at_load_p(kr, vr, Kb, kstr, Vb, vstr, ptid); else at_load<HG>(kr, vr, Kb, kstr, khs, Vb, vstr, tid); } while (0)
#define AT_STORE(buf) do { if constexpr (PAIR) at_store_p(kr, vr, buf, ptid); else at_store<HG>(kr, vr, buf, tid); } while (0)
#define AT_SYNC() do { if constexpr (PAIR) pair_sync(pcnt, ep, lane); else __syncthreads(); } while (0)
    const int r32 = lane & 31, hi = lane >> 5;
    const bf16_t* Z = (const bf16_t*)(ws + WS_Z); const bf16_t* VT = (const bf16_t*)(ws + WS_VT); bf16_t* O = (bf16_t*)(ws + WS_O);
    const int gidx = vb & 3, ubase = 32 * ((vb >> 2) & 1) + (vb >> 3);
    const int hl = (ISA && !PAIR) ? (wave >> 1) : 0, h = gidx * 4 + (wave >> 1), qblk = wave & 1;
    const int i = qblk * 32 + r32;
    const int qcol = ISA ? h * 64 : 3072 + h * 64, gcol = ISA ? 2048 + h * 64 : 4352 + h * 64, ocol = ISA ? h * 64 : 1024 + h * 64;
    const int hoff = PAIR ? pr * 64 : 0;
    const int kcol = (ISA ? 1024 + gidx * 256 : 4096 + gidx * 64) + hoff, vrow = (ISA ? gidx * 256 : 1024 + gidx * 64) + hoff;
    LAS float* tab = (LAS float*)(lds + (PAIR ? PR_TAB : AT_TAB)) + wave * 384;
    u32x4 kr[NKR], vr[NKR];
#define AT_J0(uu) (((uu) >= 512) ? 0 : ((((uu) & 255) < NP) ? NP - ((uu) & 255) : 0))
#define AT_SRC(uu, j, Kb, kstr, Vb, vstr) \
    const bf16_t* Kb; int kstr; size_t khs; const bf16_t* Vb; int vstr; \
    if ((uu) >= 512 && (j) < NP) { const int b_ = (uu) - 512; \
        if (ISA) { Kb = (const bf16_t*)(ws + WS_CAK) + ((size_t)(b_ * 512 + (j) * 64) * 1024 + gidx * 256 + hoff); kstr = 1024; khs = 64; \
                   Vb = (const bf16_t*)(ws + WS_CAVT) + ((size_t)(b_ * 1024 + gidx * 256 + hoff) * 512 + (j) * 64); vstr = 512; } \
        else     { Kb = (const bf16_t*)(ws + WS_CBK) + ((size_t)(b_ * 128 + (j) * 64) * 256 + gidx * 64); kstr = 256; khs = 64; \
                   Vb = (const bf16_t*)(ws + WS_CBVT) + ((size_t)(b_ * 256 + gidx * 64) * 128 + (j) * 64); vstr = 128; } \
    } else { const size_t R = (size_t)((uu) - NP + (j)) * 64; Kb = Z + ((size_t)(kcol >> 6) * NTOK + R) * 64; kstr = 64; khs = ZHS; Vb = VT + ((size_t)((uu) - NP + (j)) * NVC + vrow) * 64; vstr = 64; }
    { const int jf = AT_J0(ubase); AT_SRC(ubase, jf, Kb, kstr, Vb, vstr); AT_LOAD(Kb, kstr, khs, Vb, vstr); }
    bf16x8 q[4];
    { const bf16_t* qp = Z + ((size_t)(qcol >> 6) * NTOK + (size_t)ubase * 64 + i) * 64 + 8 * hi;
#pragma unroll
      for (int d0 = 0; d0 < 4; ++d0) q[d0] = *(const bf16x8*)(qp + 16 * d0); }
    float slope2 = 0.f, cval = 0.f, sink2 = 0.f;
    if (ISA) { const float* rb = (const float*)(ws + WS_TAB) + h * 320;
#pragma unroll
        for (int k = 0; k < 6; ++k) { const int t = lane + 64 * k, idx = 383 - t; tab[t] = rb[idx < 319 ? idx : 319]; }
        cval = rb[319]; }
    else { slope2 = exp2f(-0.5f * (float)(h + 1)) * LOG2E; sink2 = ((const float*)(ws + WS_SINK))[h]; }
    int cur = 0;
    for (int u = ubase; u < 520; u += 64) {
        const size_t qrow = (size_t)u * 64 + i;
        const int un = u + 64; const bool has_next = un < 520;
        AT_STORE(pbase + cur * BUFB);
        AT_SYNC();
        f32x16 o0, o1;
#pragma unroll
        for (int r = 0; r < 16; ++r) { o0[r] = 0.f; o1[r] = 0.f; }
        float m = -1e30f, l = 0.f;
        asm volatile("" :: "v"(q[0]), "v"(q[1]), "v"(q[2]), "v"(q[3]), "v"(cval), "v"(slope2), "v"(sink2));
        for (int j = AT_J0(u); j < NP; ++j) {
            { AT_SRC(u, j + 1, Kb, kstr, Vb, vstr); AT_LOAD(Kb, kstr, khs, Vb, vstr); }
            const int bias_base = (ISA ? 575 : 128) + i - 64 * j - 4 * hi;
            attn_tile<ISA, HG>(pbase + cur * BUFB, hl, q, o0, o1, m, l, bias_base, j < 4, cval, slope2, tab, r32, hi);
            AT_STORE(pbase + (cur ^ 1) * BUFB);
            AT_SYNC();
            cur ^= 1;
        }
        u32x2 gv[8]; bf16x8 qn[4];
        { const bf16_t* gp = Z + ((size_t)(gcol >> 6) * NTOK + qrow) * 64 + 4 * hi;
#pragma unroll
          for (int t = 0; t < 8; ++t) gv[t] = *(const u32x2*)(gp + (t >> 2) * 32 + 8 * (t & 3));
          const bf16_t* qp = Z + ((size_t)(qcol >> 6) * NTOK + qrow + (has_next ? 4096 : 0)) * 64 + 8 * hi;
#pragma unroll
          for (int d0 = 0; d0 < 4; ++d0) qn[d0] = *(const bf16x8*)(qp + 16 * d0); }
        { const int uu = has_next ? un : u; const int jn = AT_J0(uu); AT_SRC(uu, jn, Kb, kstr, Vb, vstr); AT_LOAD(Kb, kstr, khs, Vb, vstr); }
        { int bias_base = (ISA ? 575 : 128) + i - 64 * NP - 4 * hi; asm volatile("" : "+v"(bias_base));
          attn_tile<ISA, HG>(pbase + cur * BUFB, hl, q, o0, o1, m, l, bias_base, false, cval, slope2, tab, r32, hi); }
        AT_SYNC();
        cur ^= 1;
        const float lt = l + __shfl_xor(l, 32);
        float scale;
        if (ISA) scale = 1.0f / lt;
        else { const float mf = fmaxf(m, sink2), a = ex2(m - mf); scale = a / (lt * a + ex2(sink2 - mf)); }
        bf16_t* op = O + qrow * DM + ocol + 4 * hi;
#pragma unroll
        for (int t = 0; t < 8; ++t) {
            const int dblk = t >> 2, g = t & 3;
            float gg[4] = {__uint_as_float(gv[t].x << 16), __uint_as_float(gv[t].x & 0xffff0000u), __uint_as_float(gv[t].y << 16), __uint_as_float(gv[t].y & 0xffff0000u)};
            float ov[4];
#pragma unroll
            for (int e = 0; e < 4; ++e) { const float x = gg[e], sg = x * __builtin_amdgcn_rcpf(1.0f + ex2(-x * LOG2E));
                ov[e] = (dblk ? o1[4 * g + e] : o0[4 * g + e]) * scale * sg; }
            u32x2 w; w.x = cvt_pk(ov[0], ov[1]); w.y = cvt_pk(ov[2], ov[3]);
            *(u32x2*)(op + dblk * 32 + 8 * g) = w;
        }
#pragma unroll
        for (int d0 = 0; d0 < 4; ++d0) q[d0] = qn[d0];
    }
    if (PAIR) __syncthreads();
#undef AT_SRC
#undef AT_J0
#undef AT_LOAD
#undef AT_STORE
#undef AT_SYNC
}
__device__ __forceinline__ void attn_phase(const Params& p, LAS unsigned char* lds) {
    int tid_ = threadIdx.x; asm volatile("" : "+v"(tid_));
    const int tid = tid_, lane = tid & 63, wave = __builtin_amdgcn_readfirstlane(tid >> 6);
    const int G = gridDim.x, bx = blockIdx.x;
    unsigned char* ws = fresh_params()->ws;
    for (int vb = bx; vb < 256; vb += G) attn_stream<true, true>(ws, vb, lds, tid, lane, wave);
    for (int vb = bx; vb < 256; vb += G) attn_stream<false, false>(ws, 255 - vb, lds, tid, lane, wave);
}

__device__ __forceinline__ void phase4(const Params& p) {
    int tid_ = threadIdx.x; asm volatile("" : "+v"(tid_));
    const int tid = tid_, lane = tid & 63, wave = __builtin_amdgcn_readfirstlane(tid >> 6);
    const int gw = blockIdx.x * 8 + wave, NGW = gridDim.x * 8;
    kparams_t kp = fresh_params(); unsigned char* ws4 = kp->ws; float* out4 = kp->out;
    const float* pss = (const float*)(ws4 + WS_PSS);
    f32x4 g[8];
#pragma unroll
    for (int j = 0; j < 8; ++j) g[j] = ((const f32x4*)(ws4 + WS_GF))[lane + 64 * j];
    for (int m = NTOKP + gw; m < NTOK; m += NGW) {
        const f32x4* ys = (const f32x4*)((const float*)(ws4 + WS_XS) + (size_t)(m - NTOKP) * DM) + lane;
        f32x4 v[8]; float s = 0.f;
#pragma unroll
        for (int j = 0; j < 8; ++j) v[j] = ys[64 * j];
#pragma unroll 1
        for (int ks = 0; ks < 8; ++ks) { const f32x4* ps = (const f32x4*)((const float*)(ws4 + WS_PS) + ((size_t)ks * 512 + (m - NTOKP)) * DM) + lane;
#pragma unroll
            for (int j = 0; j < 8; ++j) v[j] += ps[64 * j]; }
#pragma unroll
        for (int j = 0; j < 8; ++j) s += (v[j][0] * v[j][0] + v[j][1] * v[j][1]) + (v[j][2] * v[j][2] + v[j][3] * v[j][3]);
        s = wave_sum(s);
        const float r = 1.0f / sqrtf(s * (1.0f / DM) + RMS_EPS);
        f32x4* y = (f32x4*)(out4 + (size_t)m * DM) + lane;
#pragma unroll
        for (int j = 0; j < 8; ++j) y[64 * j] = v[j] * r * g[j];
    }
    for (int m = gw; m < NTOKP; m += NGW) {
        float s = (lane < 32) ? pss[(size_t)m * 32 + lane] : 0.f;
        s = wave_sum(s);
        const float r = 1.0f / sqrtf(s * (1.0f / DM) + RMS_EPS);
        const u32x2* yb = (const u32x2*)((const bf16_t*)(ws4 + WS_Z) + (size_t)m * DM) + lane;
        f32x4* y = (f32x4*)(out4 + (size_t)m * DM) + lane;
        u32x2 t[8];
#pragma unroll
        for (int j = 0; j < 8; ++j) t[j] = __builtin_nontemporal_load(&yb[64 * j]);
#pragma unroll
        for (int j = 0; j < 8; ++j) { f32x4 v = {__uint_as_float(t[j].x << 16), __uint_as_float(t[j].x & 0xffff0000u), __uint_as_float(t[j].y << 16), __uint_as_float(t[j].y & 0xffff0000u)};
            __builtin_nontemporal_store(v * r * g[j], &y[64 * j]); }
    }
}

#ifndef MK_N_LAUNCHES
#define MK_N_LAUNCHES 1
#endif
#if MK_N_LAUNCHES != 1
#error "this file is the one-launch kernel: the phase seams are in-kernel barriers (the one-launch-per-phase cut of the first versions no longer exists)"
#endif
__global__ void __launch_bounds__(512, 2) mk_fwd(Params p) {
    extern __shared__ __attribute__((aligned(16))) unsigned char lds_raw[];
    LAS unsigned char* lds = (LAS unsigned char*)lds_raw;
    unsigned char* ws = p.ws;
#ifndef PH_MASK
#define PH_MASK 31
#endif
#if MK_N_LAUNCHES == 1
#define IN(k) ((PH_MASK >> (k)) & 1)
#else
#define IN(k) (((PH_MASK >> (k)) & 1) && p.ph_lo <= (k) && (k) < p.ph_hi)
#endif
#ifndef REP_MASK
#define REP_MASK 0
#endif
#define REPS(k) (((REP_MASK >> (k)) & 1) ? 2 : 1)
#define GSYNC0() cg::this_grid().sync()
#define GSYNC() do { XcdBarrier xb_; xb_.bar = (unsigned*)(fresh_params()->ws + WS_BAR); xb_.x = xb_xcc_id(); xb_.st = (volatile LAS unsigned*)(lds + MISC_OFF); xcd_barrier(xb_); } while (0)
    if (threadIdx.x < 16) ((volatile LAS unsigned*)(lds + MISC_OFF))[threadIdx.x] = 0u;
    __syncthreads();
    if (blockIdx.x == 0) for (int i = threadIdx.x; i < XCD_BAR_WORDS; i += 512) ((unsigned*)(ws + WS_BAR))[i] = 0u;
    GSYNC0();
    (void)xcd_barrier_post((unsigned*)(fresh_params()->ws + WS_BAR), (volatile LAS unsigned*)(lds + MISC_OFF));
    if (IN(0)) for (int rep = 0; rep < REPS(0); ++rep) { phase0(p, lds); GSYNC(); }
    if (IN(1)) for (int rep = 0; rep < REPS(1); ++rep) {
        { pg8::Gemm g{(const bf16_t*)(ws + WS_XB), (const bf16_t*)(ws + WS_W1T), NTOK, LDZ, DM, DM}; pg8::StaticOrder S; S.init(NTOK, LDZ, (int)gridDim.x, (int)blockIdx.x);
          pg8::EpiZ E{(bf16_t*)(ws + WS_Z), (const float*)(ws + WS_RS), p.out};
          pg8::gemm_phase<pg8::EpiZ, pg8::StaticOrder, true, true>(lds, g, S, E); }
        { pg8::Gemm g{(const bf16_t*)(ws + WS_W1T) + (size_t)LDZ * DM, (const bf16_t*)(ws + WS_XB), NVC, NTOK, DM, DM}; pg8::StaticOrder S; S.init(NVC, NTOK, (int)gridDim.x, (int)(gridDim.x - 1 - blockIdx.x));
          pg8::EpiVt E{(bf16_t*)(ws + WS_VT), (const float*)(ws + WS_RS), p.out};
          pg8::gemm_phase<pg8::EpiVt, pg8::StaticOrder, true, true>(lds, g, S, E); }
        { const int G = (int)gridDim.x, bx = (int)blockIdx.x;
          if (G == 256) { if (bx < 118) cache_phase(lds, bx, 204); else if (bx >= 170) cache_phase(lds, bx - 52, 204); }
          else cache_phase(lds, bx, G); }
        GSYNC();
    }
    if (IN(2)) for (int rep = 0; rep < REPS(2); ++rep) { attn_phase(p, lds); GSYNC(); }
    for (int rep = 0; rep < REPS(3); ++rep) {
    if (IN(3)) {
        kparams_t kp = fresh_params(); unsigned char* ws = kp->ws;
        { pg8::Gemm g{(const bf16_t*)(ws + WS_O), (const bf16_t*)(ws + WS_W2T), NTOKP, DM, DM, DM}; pg8::StaticOrder S; S.init(NTOKP, DM, (int)gridDim.x, (int)blockIdx.x);
          pg8::EpiY E{kp->in[0], (const float*)(ws + WS_XS), (bf16_t*)(ws + WS_Z), (float*)(ws + WS_PSS)};
          pg8::gemm_phase<pg8::EpiY, pg8::StaticOrder, true, true>(lds, g, S, E); }
        { pg8::Gemm g{(const bf16_t*)(ws + WS_O), (const bf16_t*)(ws + WS_W2T), NTOK, DM, 256, DM}; pg8::SplitK8 S{(int)gridDim.x, (int)(gridDim.x - 1 - blockIdx.x)};
          pg8::EpiYS E{(float*)(ws + WS_PS)};
          pg8::gemm_phase<pg8::EpiYS, pg8::SplitK8, false, true>(lds, g, S, E); }
        GSYNC();
    }
    if (IN(4)) { phase4(p); if (rep + 1 < REPS(3)) GSYNC(); }
    }
#undef IN
}

extern "C" void kernel_launch(void* const* d_in, const int* in_sizes, int n_in, void* d_out, int out_size, void* d_ws, size_t ws_size, hipStream_t stream) {
    static int grid = 0;
    if (grid == 0) {
        if (n_in != 12 || ws_size < WS_END) { fprintf(stderr, "kernel_launch: bad arguments (n_in %d, ws %zu < %zu)\n", n_in, ws_size, (size_t)WS_END); grid = -1; return; }
        int dev = 0, cus = 0, per_cu = 0;
        if (hipGetDevice(&dev) != hipSuccess || hipDeviceGetAttribute(&cus, hipDeviceAttributeMultiprocessorCount, dev) != hipSuccess) { grid = -1; return; }
        if (hipFuncSetAttribute((const void*)mk_fwd, hipFuncAttributeMaxDynamicSharedMemorySize, LDS_BYTES) != hipSuccess) { fprintf(stderr, "kernel_launch: hipFuncSetAttribute failed\n"); grid = -1; return; }
        if (hipOccupancyMaxActiveBlocksPerMultiprocessor(&per_cu, (const void*)mk_fwd, 512, LDS_BYTES) != hipSuccess || per_cu < 1) { fprintf(stderr, "kernel_launch: occupancy query failed (%d)\n", per_cu); grid = -1; return; }
        grid = cus * per_cu;
    }
    if (grid < 0) return;
    Params p{};
    for (int i = 0; i < 12; ++i) p.in[i] = (const float*)d_in[i];
    p.out = (float*)d_out; p.ws = (unsigned char*)d_ws;
#if MK_N_LAUNCHES == 1
    p.ph_lo = 0; p.ph_hi = 5;
    void* args[] = {&p};
    hipError_t e = hipLaunchCooperativeKernel((const void*)mk_fwd, dim3(grid), dim3(512), args, LDS_BYTES, stream);
    if (e != hipSuccess) fprintf(stderr, "cooperative launch failed: %s (grid %d)\n", hipGetErrorString(e), grid);
#else
    for (int li = 0; li < 5; ++li) { p.ph_lo = li; p.ph_hi = li + 1; hipLaunchKernelGGL(mk_fwd, dim3(grid), dim3(512), LDS_BYTES, stream, p); }
#endif
}
```

```cpp
#include <hip/hip_runtime.h>
#include <hip/hip_cooperative_groups.h>
#include <cstdio>
#include <cstdint>
namespace cg = cooperative_groups;

#define LAS __attribute__((address_space(3)))
typedef unsigned short bf16_t;
typedef short bf16x8 __attribute__((ext_vector_type(8)));
typedef float f32x4 __attribute__((ext_vector_type(4)));
typedef float f32x16 __attribute__((ext_vector_type(16)));
typedef unsigned u32x4 __attribute__((ext_vector_type(4)));
typedef unsigned u32x2 __attribute__((ext_vector_type(2)));

constexpr int DM = 2048, NTOKP = 32768, NTOK = 33280;
constexpr int LDZ = 5376;
constexpr size_t ZHS = (size_t)33280 * 64;
constexpr int NVC = 1280, LDV = NTOK;
constexpr float LOG2E = 1.4426950408889634f;
constexpr float C2 = 0.125f * LOG2E;
constexpr float RMS_EPS = 1e-6f;
constexpr size_t OFF_AKP = 68157440, OFF_AVP = 69206016, OFF_BKP = 70254592, OFF_BVP = 70320128,
                 OFF_AKS = 70385664, OFF_AVS = 74579968, OFF_BKS = 78774272, OFF_BVS = 79036416;
constexpr size_t MiB = 1u << 20;
constexpr size_t WS_XB = 0, WS_O = 0, WS_W1T = 130 * MiB, WS_W2T = 156 * MiB, WS_Z = 164 * MiB, WS_VT = WS_Z + 357826560,
                 WS_CAK = WS_VT + 85196800, WS_CAVT = WS_CAK + 8 * MiB, WS_CBK = WS_CAVT + 8 * MiB, WS_CBVT = WS_CBK + MiB / 2,
                 WS_RS = WS_CBVT + MiB / 2, WS_PSS = WS_RS + MiB, WS_XS = WS_PSS + 5 * MiB, WS_TAB = WS_XS + 4 * MiB, WS_SINK = WS_TAB + 32768, WS_GF = WS_SINK + 4096, WS_PS = WS_GF + 8192, WS_BAR = WS_PS + 32 * MiB, WS_END = WS_BAR + 16384;
constexpr int MISC_OFF = 159744, LDS_BYTES = 159744 + 64;

struct Params { const float* in[12]; float* out; unsigned char* ws; int ph_lo, ph_hi; };

__device__ __forceinline__ unsigned cvt_pk(float lo, float hi) {
    typedef float f2 __attribute__((ext_vector_type(2))); typedef __bf16 b2 __attribute__((ext_vector_type(2)));
    f2 v = {lo, hi}; b2 b = __builtin_convertvector(v, b2); return __builtin_bit_cast(unsigned, b);
}
__device__ __forceinline__ float bf2f(unsigned short b) { return __uint_as_float((unsigned)b << 16); }
__device__ __forceinline__ float wave_sum(float v) {
#pragma unroll
    for (int o = 1; o < 64; o <<= 1) v += __shfl_xor(v, o);
    return v;
}
#define LDS_WAIT() asm volatile("s_waitcnt lgkmcnt(0)" ::: "memory")
typedef const __attribute__((address_space(4))) Params* kparams_t;
__device__ __forceinline__ kparams_t fresh_params() { kparams_t kp = (kparams_t)__builtin_amdgcn_kernarg_segment_ptr(); asm volatile("" : "+s"(kp)); return kp; }

#define XB_TMO      128
#define XB_XCNT(j)  (256  + 64 * (j))
#define XB_XSUB(j)  (1280 + 64 * (j))
#define XB_XGEN(j)  (2304 + 64 * (j))
#define XB_TOP      3328
#define XB_TOPGEN   3392
#define XCD_BAR_WORDS 3456
#define XB_SPIN_CAP (1u << 18)

__device__ __forceinline__ unsigned xb_ld(unsigned* p)              { return __hip_atomic_load(p, __ATOMIC_RELAXED, __HIP_MEMORY_SCOPE_AGENT); }
__device__ __forceinline__ unsigned xb_add(unsigned* p, unsigned v) { return __hip_atomic_fetch_add(p, v, __ATOMIC_RELAXED, __HIP_MEMORY_SCOPE_AGENT); }
__device__ __forceinline__ unsigned xb_xcc_id() { return (unsigned)__builtin_amdgcn_s_getreg((3 << 11) | 20) & 0xFu; }
#define XB_SPIN(cond, bar) do { unsigned _sp = 0; while (cond) { __builtin_amdgcn_s_sleep(1); \
    if ((++_sp & 255u) == 0u) { if (xb_ld(&(bar)[XB_TMO])) break; if (_sp > XB_SPIN_CAP) { atomicAdd(&(bar)[XB_TMO], 1u); break; } } } } while (0)

struct XcdBarrier {
    unsigned* bar; unsigned x;
    volatile LAS unsigned* st;
};

__device__ __forceinline__ XcdBarrier xcd_barrier_post(unsigned* bar, volatile LAS unsigned* st) {
    XcdBarrier b; b.bar = bar; b.x = xb_xcc_id(); b.st = st;
    if (threadIdx.x == 0) (void)xb_add(&bar[XB_XCNT(b.x)], 1u);
    return b;
}
__device__ __forceinline__ void xcd_barrier_complete(unsigned* bar, unsigned x, unsigned& nloc, unsigned& nx) {
    const unsigned G = gridDim.x * gridDim.y * gridDim.z;
    unsigned sum, cnt, mine, sp = 0u;
    for (;;) {
        sum = 0u; cnt = 0u; mine = 0u;
#pragma unroll
        for (unsigned j = 0; j < 16; ++j) { const unsigned c = xb_ld(&bar[XB_XCNT(j)]); sum += c; cnt += (c > 0u) ? 1u : 0u; mine = (j == x) ? c : mine; }
        if (sum == G) break;
        __builtin_amdgcn_s_sleep(1);
        if ((++sp & 255u) == 0u) { if (xb_ld(&bar[XB_TMO])) break; if (sp > XB_SPIN_CAP) { atomicAdd(&bar[XB_TMO], 1u); break; } }
    }
    nloc = mine > 0u ? mine : 1u; nx = cnt > 0u ? cnt : 1u;
}

__device__ __forceinline__ void xcd_barrier(const XcdBarrier& b) {
    asm volatile("s_waitcnt vmcnt(0)" ::: "memory");
    __syncthreads();
    if (threadIdx.x == 0) {
        unsigned* bar = b.bar;
        __builtin_amdgcn_s_waitcnt(0);
        unsigned nloc = b.st[0], nx = b.st[1];
        if (nloc == 0u) { xcd_barrier_complete(bar, b.x, nloc, nx); b.st[0] = nloc; b.st[1] = nx; }
        const unsigned old = xb_add(&bar[XB_XSUB(b.x)], 1u);
        const unsigned gen = old / nloc;
        if (old + 1u == (gen + 1u) * nloc) {
            __builtin_amdgcn_fence(__ATOMIC_RELEASE, "agent");
            asm volatile("s_waitcnt vmcnt(0)" ::: "memory");
            const unsigned og = xb_add(&bar[XB_TOP], 1u);
            const unsigned tg = og / nx;
            if (og + 1u == (tg + 1u) * nx) xb_add(&bar[XB_TOPGEN], 1u);
            else XB_SPIN(xb_ld(&bar[XB_TOPGEN]) == tg, bar);
            __builtin_amdgcn_fence(__ATOMIC_ACQUIRE, "agent");
            xb_add(&bar[XB_XGEN(b.x)], 1u);
            asm volatile("s_waitcnt vmcnt(0)" ::: "memory");
        } else {
            XB_SPIN(xb_ld(&bar[XB_XGEN(b.x)]) == gen, bar);
            __builtin_amdgcn_fence(__ATOMIC_ACQUIRE, "agent");
            asm volatile("s_waitcnt vmcnt(0)" ::: "memory");
        }
    }
    __syncthreads();
}


namespace pg8 {
#define PG8_LAS __attribute__((address_space(3)))
typedef unsigned short bf16_t;
typedef short bf16x8 __attribute__((ext_vector_type(8)));
typedef float f32x4 __attribute__((ext_vector_type(4)));
typedef unsigned u32x4 __attribute__((ext_vector_type(4)));
constexpr int BM = 256, BK = 64, HALF = 128, HTB = HALF * BK * 2  , STAGE_BYTES = 8 * HTB, NXCD = 8, WGM = 8;

__host__ __device__ __forceinline__ int lds_byte(int r, int c) { const int st = (r >> 4) * 2 + (c >> 5), rr = r & 15, cc = c & 31, ob = rr * 64 + cc * 2; return st * 1024 + (ob ^ (((ob >> 9) & 1) << 5)); }
__host__ __device__ __forceinline__ void stage_rc(int b, int& R, int& C) { const int st = b / 1024, sb = b % 1024, swz = sb ^ (((sb >> 9) & 1) << 5); R = (st >> 1) * 16 + swz / 64; C = (st & 1) * 32 + (swz % 64) / 2; }
__host__ __device__ __forceinline__ int perm32(int rho) { const int n = rho >> 4, i = rho & 15; return 8 * (i >> 2) + 4 * n + (i & 3); }

struct Unit { int pm, pn, ko; };
struct Gemm { const bf16_t* A; const bf16_t* Bt; int M, N, K, ld; };

struct StaticOrder {
    int nM, nN, nwg, G, c;
    __host__ __device__ __forceinline__ void init(int M, int N, int G_, int c_) { nM = M / BM; nN = N / BM; nwg = nM * nN; G = G_; c = c_; }
    __host__ __device__ __forceinline__ bool next(int i, Unit& u) const {
        const long L = (long)i * G + c; if (L >= nwg) return false;
        int wgid = (int)L; { const int q = nwg / NXCD, r = nwg % NXCD, xcd = wgid % NXCD, off = wgid / NXCD; wgid = (xcd < r ? xcd * (q + 1) : r * (q + 1) + (xcd - r) * q) + off; }
        const int nig = WGM * nN, gid = wgid / nig, fm = gid * WGM, gsz = (nM - fm) < WGM ? (nM - fm) : WGM;
        u.pm = fm + ((wgid % nig) % gsz); u.pn = (wgid % nig) / gsz; u.ko = 0; return true;
    }
    __device__ __forceinline__ void a_ready(const Unit&) const {}
    __device__ __forceinline__ void done(const Unit&) const {}
};

}
namespace pg8 {
struct EpiZ {
    static constexpr bool PERM = true, AFTER_DRAIN = false;
    bf16_t* Z; const float* rs; float* out;
    __device__ __forceinline__ void operator()(const f32x4 (&acc)[2][2][4][2], const Unit& u, int wr, int wc, int fr, int fq) const {
        const int row0 = u.pm * BM + wr * 64 + fr;
        const int col0 = u.pn * BM + wc * 32 + 8 * fq;
        const bool isKa = (u.pn >= 4 && u.pn < 8), isKb = (u.pn == 16);
        const bool ctile = (isKa || isKb) && (u.pm >= 128 || (u.pm & 63) >= 62);
#pragma unroll
        for (int ai = 0; ai < 2; ++ai)
#pragma unroll
            for (int m = 0; m < 4; ++m) {
                const int r = row0 + ai * HALF + m * 16;
#pragma unroll
                for (int bj = 0; bj < 2; ++bj) {
                    const f32x4 v0 = acc[ai][bj][m][0], v1 = acc[ai][bj][m][1];
                    u32x4 w; w.x = cvt_pk(v0[0], v0[1]); w.y = cvt_pk(v0[2], v0[3]); w.z = cvt_pk(v1[0], v1[1]); w.w = cvt_pk(v1[2], v1[3]);
                    { const int cc = col0 + bj * HALF; *(u32x4*)(Z + ((size_t)(cc >> 6) * NTOK + r) * 64 + (cc & 63)) = w; }
                    if (ctile) {
                        float* dst = nullptr; const int c = col0 + bj * HALF;
                        if (r >= NTOKP) { const int sidx = r - NTOKP, b = sidx >> 6, i = sidx & 63;
                            dst = isKa ? out + OFF_AKS + ((size_t)(b * 512 + 448 + i) * 1024 + (c - 1024)) : out + OFF_BKS + ((size_t)(b * 128 + 64 + i) * 256 + (c - 4096)); }
                        else { const int b = r >> 14, t = r & 16383;
                            if (isKa) { if (t >= 15872) dst = out + OFF_AKP + ((size_t)(b * 512 + t - 15872) * 1024 + (c - 1024)); }
                            else      { if (t >= 16256) dst = out + OFF_BKP + ((size_t)(b * 128 + t - 16256) * 256 + (c - 4096)); } }
                        if (dst) { *(f32x4*)dst = v0; *(f32x4*)(dst + 4) = v1; }
                    }
                }
            }
    }
};
struct EpiVt {
    static constexpr bool PERM = true, AFTER_DRAIN = false;
    bf16_t* VT; const float* rs; float* out;
    __device__ __forceinline__ void operator()(const f32x4 (&acc)[2][2][4][2], const Unit& u, int wr, int wc, int fr, int fq) const {
        const int row0 = u.pm * BM + wr * 64 + fr;
        const int tok0 = u.pn * BM + wc * 32 + 8 * fq;
        const bool ctile = (u.pn >= 128 || (u.pn & 63) >= 62);
#pragma unroll
        for (int ai = 0; ai < 2; ++ai)
#pragma unroll
            for (int m = 0; m < 4; ++m) {
                const int r = row0 + ai * HALF + m * 16;
#pragma unroll
                for (int bj = 0; bj < 2; ++bj) {
                    const f32x4 v0 = acc[ai][bj][m][0], v1 = acc[ai][bj][m][1];
                    u32x4 w; w.x = cvt_pk(v0[0], v0[1]); w.y = cvt_pk(v0[2], v0[3]); w.z = cvt_pk(v1[0], v1[1]); w.w = cvt_pk(v1[2], v1[3]);
                    { const int tk0 = tok0 + bj * HALF; *(u32x4*)(VT + ((size_t)(tk0 >> 6) * NVC + r) * 64 + (tk0 & 63)) = w; }
                    if (ctile) {
#pragma unroll
                        for (int e = 0; e < 8; ++e) {
                            const int tk = tok0 + bj * HALF + e; const float val = e < 4 ? v0[e & 3] : v1[e & 3];
                            if (tk >= NTOKP) { const int sidx = tk - NTOKP, b = sidx >> 6, i = sidx & 63;
                                if (r < 1024) out[OFF_AVS + (size_t)(b * 512 + 448 + i) * 1024 + r] = val;
                                else          out[OFF_BVS + (size_t)(b * 128 + 64 + i) * 256 + (r - 1024)] = val; }
                            else { const int b = tk >> 14, t = tk & 16383;
                                if (r < 1024) { if (t >= 15872) out[OFF_AVP + (size_t)(b * 512 + t - 15872) * 1024 + r] = val; }
                                else          { if (t >= 16256) out[OFF_BVP + (size_t)(b * 128 + t - 16256) * 256 + (r - 1024)] = val; } }
                        }
                    }
                }
            }
    }
};
struct SplitK8 {
    int G, c;
    __device__ __forceinline__ bool next(int i, Unit& u) const { const int L = i * G + c; if (L >= 128) return false; const int t = L >> 3; u.pm = 128 + (t >> 3); u.pn = t & 7; u.ko = 256 * (L & 7); return true; }
    __device__ __forceinline__ void a_ready(const Unit&) const {}
    __device__ __forceinline__ void done(const Unit&) const {}
};
struct EpiYS {
    static constexpr bool PERM = false, AFTER_DRAIN = false;
    float* YS;
    __device__ __forceinline__ void operator()(const f32x4 (&acc)[2][2][4][2], const Unit& u, int wr, int wc, int fr, int fq) const {
        const int col0 = u.pn * BM + wc * 32 + 4 * fq;
#pragma unroll
        for (int ai = 0; ai < 2; ++ai)
#pragma unroll
            for (int m = 0; m < 4; ++m) {
                float* yrow = YS + ((size_t)(u.ko >> 8) * 512 + (u.pm - 128) * BM + ai * HALF + wr * 64 + m * 16 + fr) * DM + col0;
#pragma unroll
                for (int bj = 0; bj < 2; ++bj)
#pragma unroll
                    for (int n = 0; n < 2; ++n) *(f32x4*)(yrow + bj * HALF + n * 16) = acc[ai][bj][m][n];
            }
    }
};
struct EpiY {
    static constexpr bool PERM = true, AFTER_DRAIN = false;
    const float* xp; const float* xs; bf16_t* YB; float* pss;
    __device__ __forceinline__ const float* xrow(int r) const { return (r < NTOKP) ? xp + (size_t)r * DM : xs + (size_t)(r - NTOKP) * DM; }
    __device__ __forceinline__ void operator()(const f32x4 (&acc)[2][2][4][2], const Unit& u, int wr, int wc, int fr, int fq) const {
        const int col0 = u.pn * BM + wc * 32 + 8 * fq;
        const int rbase = u.pm * BM + wr * 64 + fr;
        f32x4 xv[2][2];
        { const float* xr = xrow(rbase) + col0; xv[0][0] = __builtin_nontemporal_load((const f32x4*)(xr)); xv[0][1] = __builtin_nontemporal_load((const f32x4*)(xr + 4)); }
        float q = 0.f;
#pragma unroll
        for (int s2 = 0; s2 < 16; ++s2) {
            const int g = s2 >> 1, bj = s2 & 1, ai = g >> 2, m = g & 3, cb = s2 & 1;
            if (s2 + 1 < 16) { const int g1 = (s2 + 1) >> 1, bj1 = (s2 + 1) & 1; const int r1 = rbase + (g1 >> 2) * HALF + (g1 & 3) * 16; const float* xr = xrow(r1) + col0 + bj1 * HALF;
                xv[cb ^ 1][0] = __builtin_nontemporal_load((const f32x4*)(xr)); xv[cb ^ 1][1] = __builtin_nontemporal_load((const f32x4*)(xr + 4)); }
            const int r = rbase + ai * HALF + m * 16;
            const f32x4 y0 = xv[cb][0] + acc[ai][bj][m][0], y1 = xv[cb][1] + acc[ai][bj][m][1];
            u32x4 w; w.x = cvt_pk(y0[0], y0[1]); w.y = cvt_pk(y0[2], y0[3]); w.z = cvt_pk(y1[0], y1[1]); w.w = cvt_pk(y1[2], y1[3]);
            *(u32x4*)(YB + (size_t)r * DM + col0 + bj * HALF) = w;
            q += (y0[0] * y0[0] + y0[1] * y0[1]) + (y0[2] * y0[2] + y0[3] * y0[3]) + (y1[0] * y1[0] + y1[1] * y1[1]) + (y1[2] * y1[2] + y1[3] * y1[3]);
            if (bj == 1) { q += __shfl_xor(q, 16); q += __shfl_xor(q, 32); if (fq == 0) pss[(size_t)r * 32 + u.pn * 4 + wc] = q; q = 0.f; }
        }
    }
};
}

namespace pg8 {
template <class Epi, class Sched, bool ALIGN_EPI = false, bool SP2 = false>
__device__ __forceinline__ void gemm_phase(PG8_LAS unsigned char* lds, const Gemm g, const Sched& S, const Epi& E) {
    int tid_ = threadIdx.x; asm volatile("" : "+v"(tid_)); const int tid = tid_, wid = __builtin_amdgcn_readfirstlane(tid >> 6), lane = tid & 63, wr = wid >> 2, wc = wid & 3, fr = lane & 15, fq = lane >> 4;
    const int K = g.K, nt = K / BK, LD = g.ld;
    unsigned voffA[2], voffB[2];
#pragma unroll
    for (int i = 0; i < 2; ++i) { int R, C; stage_rc(tid * 16 + i * 8192, R, C); const int Rb = Epi::PERM ? ((R & ~31) + perm32(R & 31)) : R;
        voffA[i] = (unsigned)(R * LD + C) * 2u; voffB[i] = (unsigned)(Rb * LD + C) * 2u; }
    const size_t kstep = (size_t)(BK * 2);
    const size_t hstep = (size_t)HALF * LD * 2;
    const size_t tstep = 2 * hstep;
    const unsigned ldsw = (unsigned)wid * 1024u;
    const int aoff = lds_byte(wr * 64 + fr, fq * 8), boff = lds_byte(wc * 32 + fr, fq * 8);
#define PG8_SA(b, h) (((b) * 2 + (h)) * HTB)
#define PG8_SB(b, h) ((4 + (b) * 2 + (h)) * HTB)
#define PG8_STAGE(bufoff, gbase, voff) do { _Pragma("unroll") for (int _i = 0; _i < 2; ++_i) \
        __builtin_amdgcn_global_load_lds((const unsigned*)((const char*)(gbase) + (voff)[_i]), (PG8_LAS unsigned*)(lds + (bufoff) + ldsw + _i * 8192), 16, 0, 0); } while (0)
#define PG8_LDA(dst, b, h) do { _Pragma("unroll") for (int m = 0; m < 4; ++m) _Pragma("unroll") for (int k = 0; k < 2; ++k) dst[m][k] = *(const PG8_LAS bf16x8*)(lds + PG8_SA(b, h) + aoff + m * 2048 + k * 1024); } while (0)
#define PG8_LDB(dst, b, h) do { _Pragma("unroll") for (int n = 0; n < 2; ++n) _Pragma("unroll") for (int k = 0; k < 2; ++k) dst[n][k] = *(const PG8_LAS bf16x8*)(lds + PG8_SB(b, h) + boff + n * 2048 + k * 1024); } while (0)
#define PG8_MMA(ai, bj, At, Bt) do { __builtin_amdgcn_s_setprio(1); _Pragma("unroll") for (int m = 0; m < 4; ++m) _Pragma("unroll") for (int n = 0; n < 2; ++n) _Pragma("unroll") for (int k = 0; k < 2; ++k) \
        acc[ai][bj][m][n] = __builtin_amdgcn_mfma_f32_16x16x32_bf16(Bt[n][k], At[m][k], acc[ai][bj][m][n], 0, 0, 0); __builtin_amdgcn_s_setprio(0); } while (0)
#define PG8_WAIT_V(n) asm volatile("s_waitcnt vmcnt(" #n ")" ::: "memory")
#define PG8_WAIT_L(n) asm volatile("s_waitcnt lgkmcnt(" #n ")" ::: "memory")
#define PG8_BAR __builtin_amdgcn_s_barrier()
#define PG8_SCHED __builtin_amdgcn_sched_barrier(0)
    Unit cur, nxt; int ui = 0;
    if (!S.next(0, cur)) return;
    f32x4 acc[2][2][4][2];
#pragma unroll
    for (int a = 0; a < 2; ++a)
#pragma unroll
        for (int b = 0; b < 2; ++b)
#pragma unroll
            for (int m = 0; m < 4; ++m)
#pragma unroll
                for (int n = 0; n < 2; ++n) acc[a][b][m][n] = (f32x4){0.f, 0.f, 0.f, 0.f};
    bf16x8 At[4][2], B0[2][2], B1[2][2];
    const char* cA = (const char*)g.A + (size_t)cur.pm * tstep + (size_t)cur.ko * 2; const char* cB = (const char*)g.Bt + (size_t)cur.pn * tstep + (size_t)cur.ko * 2;
    S.a_ready(cur);
    if constexpr (SP2) {
        PG8_STAGE(PG8_SB(0, 0), cB, voffB); PG8_STAGE(PG8_SB(0, 1), cB + hstep, voffB); PG8_STAGE(PG8_SA(0, 0), cA, voffA); PG8_STAGE(PG8_SA(0, 1), cA + hstep, voffA);
        if (wr == 1) PG8_BAR;
        PG8_WAIT_V(2); PG8_BAR;
        PG8_STAGE(PG8_SB(1, 0), cB + kstep, voffB); PG8_STAGE(PG8_SA(1, 0), cA + kstep, voffA); PG8_STAGE(PG8_SB(1, 1), cB + hstep + kstep, voffB);
        PG8_WAIT_V(6); PG8_BAR;
    } else {
        PG8_STAGE(PG8_SB(0, 0), cB, voffB); PG8_STAGE(PG8_SA(0, 0), cA, voffA); PG8_STAGE(PG8_SB(0, 1), cB + hstep, voffB); PG8_STAGE(PG8_SA(0, 1), cA + hstep, voffA);
        if (wr == 1) PG8_BAR;
        PG8_WAIT_V(4); PG8_BAR;
        PG8_STAGE(PG8_SB(1, 0), cB + kstep, voffB); PG8_STAGE(PG8_SA(1, 0), cA + kstep, voffA); PG8_STAGE(PG8_SB(1, 1), cB + hstep + kstep, voffB);
        PG8_WAIT_V(6); PG8_BAR;
    }
    for (;;) {
        const bool has_next = S.next(ui + 1, nxt);
        const char* nA = has_next ? (const char*)g.A + (size_t)nxt.pm * tstep + (size_t)nxt.ko * 2 : cA; const char* nB = has_next ? (const char*)g.Bt + (size_t)nxt.pn * tstep + (size_t)nxt.ko * 2 : cB;
        for (int t = 0; t < nt; t += 2) {
            const bool last = (t == nt - 2);
            const char* a1 = cA + (size_t)(t + 1) * kstep;
            const char* a2 = last ? nA : cA + (size_t)(t + 2) * kstep; const char* b2 = last ? nB : cB + (size_t)(t + 2) * kstep;
            const char* a3 = a2 + kstep; const char* b3 = b2 + kstep;
            if (last && has_next) S.a_ready(nxt);
            if constexpr (SP2) {
            PG8_LDB(B0, 0, 0); PG8_LDB(B1, 0, 1); PG8_SCHED; PG8_LDA(At, 0, 0); PG8_STAGE(PG8_SA(1, 1), a1 + hstep, voffA);
            PG8_WAIT_V(8); PG8_WAIT_L(0); PG8_BAR; PG8_MMA(0, 0, At, B0); PG8_MMA(0, 1, At, B1); PG8_BAR; PG8_SCHED;
            PG8_LDA(At, 0, 1); PG8_STAGE(PG8_SB(0, 0), b2, voffB); PG8_STAGE(PG8_SB(0, 1), b2 + hstep, voffB); PG8_STAGE(PG8_SA(0, 0), a2, voffA);
            PG8_WAIT_V(8); PG8_WAIT_L(0); PG8_BAR; PG8_MMA(1, 0, At, B0); PG8_MMA(1, 1, At, B1); PG8_BAR; PG8_SCHED;
            PG8_LDB(B0, 1, 0); PG8_LDB(B1, 1, 1); PG8_SCHED; PG8_LDA(At, 1, 0); PG8_STAGE(PG8_SA(0, 1), a2 + hstep, voffA);
            PG8_WAIT_V(8); PG8_WAIT_L(0); PG8_BAR; PG8_MMA(0, 0, At, B0); PG8_MMA(0, 1, At, B1); PG8_BAR; PG8_SCHED;
            PG8_LDA(At, 1, 1); PG8_STAGE(PG8_SB(1, 0), b3, voffB); PG8_STAGE(PG8_SB(1, 1), b3 + hstep, voffB); PG8_STAGE(PG8_SA(1, 0), a3, voffA);
            PG8_WAIT_V(8); PG8_WAIT_L(0); PG8_BAR; PG8_MMA(1, 0, At, B0); PG8_MMA(1, 1, At, B1); PG8_BAR; PG8_SCHED;
            } else {
            PG8_LDB(B0, 0, 0); PG8_SCHED; PG8_LDA(At, 0, 0); PG8_STAGE(PG8_SA(1, 1), a1 + hstep, voffA);
            PG8_WAIT_L(8); PG8_BAR; PG8_WAIT_L(0); PG8_MMA(0, 0, At, B0); PG8_BAR; PG8_SCHED;
            PG8_LDB(B1, 0, 1); PG8_STAGE(PG8_SB(0, 0), b2, voffB);
            PG8_BAR; PG8_WAIT_L(0); PG8_MMA(0, 1, At, B1); PG8_BAR;
            PG8_LDA(At, 0, 1); PG8_STAGE(PG8_SA(0, 0), a2, voffA);
            PG8_BAR; PG8_WAIT_L(0); PG8_MMA(1, 0, At, B0); PG8_BAR; PG8_SCHED;
            PG8_STAGE(PG8_SB(0, 1), b2 + hstep, voffB);
            PG8_WAIT_V(6); PG8_BAR; PG8_MMA(1, 1, At, B1); PG8_BAR;
            PG8_LDB(B0, 1, 0); PG8_SCHED; PG8_LDA(At, 1, 0); PG8_STAGE(PG8_SA(0, 1), a2 + hstep, voffA);
            PG8_WAIT_L(8); PG8_BAR; PG8_WAIT_L(0); PG8_MMA(0, 0, At, B0); PG8_BAR; PG8_SCHED;
            PG8_LDB(B1, 1, 1); PG8_STAGE(PG8_SB(1, 0), b3, voffB);
            PG8_BAR; PG8_WAIT_L(0); PG8_MMA(0, 1, At, B1); PG8_BAR;
            PG8_LDA(At, 1, 1); PG8_STAGE(PG8_SA(1, 0), a3, voffA);
            PG8_BAR; PG8_WAIT_L(0); PG8_MMA(1, 0, At, B0); PG8_BAR; PG8_SCHED;
            PG8_STAGE(PG8_SB(1, 1), b3 + hstep, voffB);
            PG8_WAIT_V(6); PG8_BAR; PG8_MMA(1, 1, At, B1); PG8_BAR;
            }
        }
        if constexpr (ALIGN_EPI) { if (wr == 0) PG8_BAR; }
        if constexpr (!Epi::AFTER_DRAIN) { E(acc, cur, wr, wc, fr, fq); S.done(cur); }
        if (!has_next) break;
#pragma unroll
        for (int a = 0; a < 2; ++a)
#pragma unroll
            for (int b = 0; b < 2; ++b)
#pragma unroll
                for (int m = 0; m < 4; ++m)
#pragma unroll
                    for (int n = 0; n < 2; ++n) acc[a][b][m][n] = (f32x4){0.f, 0.f, 0.f, 0.f};
        cur = nxt; cA = nA; cB = nB; ++ui;
        if constexpr (ALIGN_EPI) { if (wr == 1) PG8_BAR; }
    }
    PG8_WAIT_V(0);
    if constexpr (!ALIGN_EPI) { if (wr == 0) PG8_BAR; }
    PG8_BAR;
    if constexpr (Epi::AFTER_DRAIN) { E.fused(acc, cur, wr, wc, fr, fq, lds, wid, lane); S.done(cur); }
#undef PG8_SA
#undef PG8_SB
#undef PG8_STAGE
#undef PG8_LDA
#undef PG8_LDB
#undef PG8_MMA
#undef PG8_WAIT_V
#undef PG8_WAIT_L
#undef PG8_BAR
#undef PG8_SCHED
}
}
__device__ __forceinline__ void transpose_item(const float* __restrict__ W, int N, bf16_t* __restrict__ WT, int ldt, LAS float* scr, int k0, int n0, int dest_row0,
                                               const float* __restrict__ gain, float mul, int lane) {
    f32x4 v[8];
#pragma unroll
    for (int i = 0; i < 8; ++i) { const int pp = lane + 64 * i, kk = pp >> 3, c4 = pp & 7; v[i] = __builtin_nontemporal_load((const f32x4*)(W + (size_t)(k0 + kk) * N + n0 + 4 * c4)); }
#pragma unroll
    for (int i = 0; i < 8; ++i) { const int pp = lane + 64 * i, kk = pp >> 3, c4 = pp & 7; const float g = gain ? gain[k0 + kk] * mul : mul;
        LAS float* d = scr + kk * 33 + 4 * c4; d[0] = v[i][0] * g; d[1] = v[i][1] * g; d[2] = v[i][2] * g; d[3] = v[i][3] * g; }
    LDS_WAIT(); asm volatile("" ::: "memory");
    const int c = lane & 7;
#pragma unroll
    for (int j = 0; j < 4; ++j) { const int n = (lane >> 3) + 8 * j; const LAS float* s = scr + (8 * c) * 33 + n;
        u32x4 o; o.x = cvt_pk(s[0 * 33], s[1 * 33]); o.y = cvt_pk(s[2 * 33], s[3 * 33]); o.z = cvt_pk(s[4 * 33], s[5 * 33]); o.w = cvt_pk(s[6 * 33], s[7 * 33]);
        *(u32x4*)(WT + (size_t)(dest_row0 + n) * ldt + k0 + 8 * c) = o; }
    LDS_WAIT(); asm volatile("" ::: "memory");
}
__device__ __forceinline__ int permcol(int n) {
    if (n < 2048) return n;
    if (n < 3072) return 5376 + (n - 2048);
    if (n < 4096) return 2048 + (n - 3072);
    if (n < 5120) return 3072 + (n - 4096);
    if (n < 5376) return 4096 + (n - 5120);
    if (n < 5632) return 6400 + (n - 5376);
    return 4352 + (n - 5632);
}
__device__ __forceinline__ void cache_copy(const float* __restrict__ src, float* __restrict__ dstf, bf16_t* __restrict__ dstb, int rows, int rowlen, int gtid, int gthreads) {
    const int per_b = rows * rowlen, n4 = 8 * per_b / 4;
    for (int i4 = gtid; i4 < n4; i4 += gthreads) {
        const int e = i4 * 4, b = e / per_b, rem = e - b * per_b, r = rem / rowlen;
        const f32x4 v = __builtin_nontemporal_load((const f32x4*)(src + e));
        if (dstb) { u32x2 w; w.x = cvt_pk(v[0], v[1]); w.y = cvt_pk(v[2], v[3]); *(u32x2*)(dstb + e) = w; }
        if (r >= 64) __builtin_nontemporal_store(v, (f32x4*)(dstf + (size_t)b * per_b + rem - 64 * rowlen));
    }
}
__device__ __forceinline__ void phase0(const Params& p, LAS unsigned char* lds) {
    int tid_ = threadIdx.x; asm volatile("" : "+v"(tid_));
    const int tid = tid_, lane = tid & 63, wave = __builtin_amdgcn_readfirstlane(tid >> 6);
    LAS float* scr = (LAS float*)(lds + wave * 16384);
    const int gw = blockIdx.x * 8 + wave, NGW = gridDim.x * 8;
    unsigned char* ws = p.ws;
    bf16_t* W1T = (bf16_t*)(ws + WS_W1T); bf16_t* W2T = (bf16_t*)(ws + WS_W2T);
    constexpr int I_W1 = 32 * 208, I_W2 = 32 * 64;
    if (wave < 4) for (int it = blockIdx.x * 4 + wave; it < I_W1 + I_W2; it += gridDim.x * 4) {
        int r = it;
        if (r < I_W1) { const int kb = r / 208, nb = r % 208, n0 = nb * 32; const bool isq = (n0 < 1024) || (n0 >= 4096 && n0 < 5120);
            transpose_item(p.in[7], 6656, W1T, 2048, scr, kb * 64, n0, permcol(n0), p.in[6], isq ? C2 : 1.0f, lane); continue; }
        r -= I_W1;
        { const int kb = r / 64, nb = r % 64; transpose_item(p.in[10], 2048, W2T, 2048, scr, kb * 64, nb * 32, nb * 32, nullptr, 1.0f, lane); }
    }
    bf16_t* XB = (bf16_t*)(ws + WS_XB);
    if (wave >= 4) for (int m = blockIdx.x * 4 + (wave - 4); m < NTOK; m += gridDim.x * 4) {
        const float* xrow = (m < NTOKP) ? p.in[0] + (size_t)m * DM : p.in[1] + (size_t)(m - NTOKP) * DM;
        const f32x4* xr = (const f32x4*)xrow + lane;
        f32x4 v[8]; float s = 0.f;
#pragma unroll
        for (int j = 0; j < 8; ++j) { v[j] = __builtin_nontemporal_load(&xr[64 * j]); s += (v[j][0] * v[j][0] + v[j][1] * v[j][1]) + (v[j][2] * v[j][2] + v[j][3] * v[j][3]); }
        s = wave_sum(s);
        const float rr = 1.0f / sqrtf(s * (1.0f / DM) + RMS_EPS);
        u32x2* o8 = (u32x2*)(XB + (size_t)m * DM) + lane;
#pragma unroll
        for (int j = 0; j < 8; ++j) { u32x2 w; w.x = cvt_pk(v[j][0] * rr, v[j][1] * rr); w.y = cvt_pk(v[j][2] * rr, v[j][3] * rr); o8[64 * j] = w; }
    }
    const int gtid = blockIdx.x * 512 + tid, gthreads = gridDim.x * 512;
    for (int i = gtid; i < 16 * 320; i += gthreads) ((float*)(ws + WS_TAB))[i] = p.in[8][i] * LOG2E;
    if (gtid < 16) ((float*)(ws + WS_SINK))[gtid] = p.in[9][gtid] * LOG2E;
    for (int i = gtid; i < DM; i += gthreads) ((float*)(ws + WS_GF))[i] = p.in[11][i];
    for (int i = gtid; i < 512 * DM / 4; i += gthreads) ((f32x4*)(ws + WS_XS))[i] = ((const f32x4*)p.in[1])[i];
}

__device__ __forceinline__ void cache_phase(LAS unsigned char* lds, int w, int nw) {
    int tid_ = threadIdx.x; asm volatile("" : "+v"(tid_));
    const int tid = tid_, lane = tid & 63, wave = __builtin_amdgcn_readfirstlane(tid >> 6);
    kparams_t kp = fresh_params(); unsigned char* ws = kp->ws; float* out = kp->out;
    const float* cak = kp->in[2]; const float* cav = kp->in[3]; const float* cbk = kp->in[4]; const float* cbv = kp->in[5];
    LAS float* scr = (LAS float*)(lds + wave * 16384);
    constexpr int I_CAV = 8 * 8 * 32, I_CBV = 8 * 2 * 8;
    for (int r = w * 8 + wave; r < I_CAV + I_CBV; r += nw * 8) {
        if (r < I_CAV) { const int b = r >> 8, q = r & 255, kb = q >> 5, nb = q & 31;
            transpose_item(cav + (size_t)b * 512 * 1024, 1024, (bf16_t*)(ws + WS_CAVT) + (size_t)b * 1024 * 512, 512, scr, kb * 64, nb * 32, nb * 32, nullptr, 1.0f, lane); }
        else { const int r2 = r - I_CAV, b = r2 >> 4, q = r2 & 15, kb = q >> 3, nb = q & 7;
            transpose_item(cbv + (size_t)b * 128 * 256, 256, (bf16_t*)(ws + WS_CBVT) + (size_t)b * 256 * 128, 128, scr, kb * 64, nb * 32, nb * 32, nullptr, 1.0f, lane); }
    }
    const int gtid = w * 512 + tid, gthreads = nw * 512;
    cache_copy(cak, out + OFF_AKS, (bf16_t*)(ws + WS_CAK), 512, 1024, gtid, gthreads);
    cache_copy(cav, out + OFF_AVS, nullptr, 512, 1024, gtid, gthreads);
    cache_copy(cbk, out + OFF_BKS, (bf16_t*)(ws + WS_CBK), 128, 256, gtid, gthreads);
    cache_copy(cbv, out + OFF_BVS, nullptr, 128, 256, gtid, gthreads);
}

#define MFMA32(a, b, c) __builtin_amdgcn_mfma_f32_32x32x16_bf16((a), (b), (c), 0, 0, 0)
__device__ __forceinline__ float ex2(float x) { return __builtin_amdgcn_exp2f(x); }
constexpr int AT_BUFB = 70656, AT_VROW = 144, AT_TAB = 2 * AT_BUFB;

template <int HG>
__device__ __forceinline__ void at_load(u32x4 (&kr)[HG], u32x4 (&vr)[HG], const bf16_t* __restrict__ Kb, int kstr, size_t khs, const bf16_t* __restrict__ Vb, int vstr, int tid) {
#pragma unroll
    for (int i = 0; i < HG; ++i) { const int pp = tid + 512 * i; const int row = pp / (HG * 8), c16 = pp % (HG * 8);
        kr[i] = *(const u32x4*)(Kb + (size_t)(c16 >> 3) * khs + (size_t)row * kstr + (c16 & 7) * 8); }
#pragma unroll
    for (int i = 0; i < HG; ++i) { const int pp = tid + 512 * i; const int row = pp >> 3, c16 = pp & 7;
        vr[i] = *(const u32x4*)(Vb + (size_t)row * vstr + c16 * 8); }
}
template <int HG>
__device__ __forceinline__ void at_store(const u32x4 (&kr)[HG], const u32x4 (&vr)[HG], LAS unsigned char* buf, int tid) {
    constexpr int RS = HG * 128 + 16, KB = 64 * RS;
#pragma unroll
    for (int i = 0; i < HG; ++i) { const int pp = tid + 512 * i; const int row = pp / (HG * 8), c16 = pp % (HG * 8);
        *(LAS u32x4*)(buf + row * RS + c16 * 16) = kr[i]; }
#pragma unroll
    for (int i = 0; i < HG; ++i) { const int pp = tid + 512 * i; const int row = pp >> 3, c16 = pp & 7;
        LAS unsigned char* d = buf + KB + row * AT_VROW + ((c16 & ~1) * 2 + (c16 & 1)) * 8;
        *(LAS u32x2*)(d) = (u32x2){vr[i].x, vr[i].y}; *(LAS u32x2*)(d + 16) = (u32x2){vr[i].z, vr[i].w}; }
}

constexpr int PR_BUFB = 9216 + 64 * AT_VROW, PR_PAIRB = 2 * PR_BUFB, PR_TAB = 4 * PR_PAIRB;
__device__ __forceinline__ void at_load_p(u32x4 (&kr)[4], u32x4 (&vr)[4], const bf16_t* __restrict__ Kb, int kstr, const bf16_t* __restrict__ Vb, int vstr, int ptid) {
#pragma unroll
    for (int i = 0; i < 4; ++i) { const int pp = ptid + 128 * i, row = pp >> 3, c16 = pp & 7; kr[i] = *(const u32x4*)(Kb + (size_t)row * kstr + c16 * 8); }
#pragma unroll
    for (int i = 0; i < 4; ++i) { const int pp = ptid + 128 * i, row = pp >> 3, c16 = pp & 7; vr[i] = *(const u32x4*)(Vb + (size_t)row * vstr + c16 * 8); }
}
__device__ __forceinline__ void at_store_p(const u32x4 (&kr)[4], const u32x4 (&vr)[4], LAS unsigned char* buf, int ptid) {
#pragma unroll
    for (int i = 0; i < 4; ++i) { const int pp = ptid + 128 * i, row = pp >> 3, c16 = pp & 7; *(LAS u32x4*)(buf + row * 144 + c16 * 16) = kr[i]; }
#pragma unroll
    for (int i = 0; i < 4; ++i) { const int pp = ptid + 128 * i, row = pp >> 3, c16 = pp & 7;
        LAS unsigned char* d = buf + 9216 + row * AT_VROW + ((c16 & ~1) * 2 + (c16 & 1)) * 8;
        *(LAS u32x2*)(d) = (u32x2){vr[i].x, vr[i].y}; *(LAS u32x2*)(d + 16) = (u32x2){vr[i].z, vr[i].w}; }
}
__device__ __forceinline__ void pair_sync(volatile LAS unsigned* cnt, unsigned& ep, int lane) {
    asm volatile("s_waitcnt lgkmcnt(0)" ::: "memory");
    ep += 2u;
    if (lane == 0) __hip_atomic_fetch_add((LAS unsigned*)cnt, 1u, __ATOMIC_RELAXED, __HIP_MEMORY_SCOPE_WORKGROUP);
    while (*cnt < ep) __builtin_amdgcn_s_sleep(1);
    asm volatile("" ::: "memory");
}

template <bool ISA, int HG>
__device__ __forceinline__ void attn_tile(const LAS unsigned char* buf, int hl, const bf16x8 (&q)[4], f32x16& o0, f32x16& o1, float& m, float& l,
                                          int bias_base, bool cbias, float cval, float slope2, const LAS float* tab, int r32, int hi) {
    constexpr int RS = HG * 128 + 16, KB = 64 * RS;
    const LAS unsigned char* kp = buf + r32 * RS + (hl * 64 + 8 * hi) * 2;
    bf16x8 k0[4], k1[4];
#pragma unroll
    for (int d0 = 0; d0 < 4; ++d0) { k0[d0] = *(const LAS bf16x8*)(kp + 32 * d0); k1[d0] = *(const LAS bf16x8*)(kp + 32 * RS + 32 * d0); }
    f32x16 s0, s1;
    if (ISA) {
        if (cbias) {
#pragma unroll
            for (int r = 0; r < 16; ++r) { s0[r] = 0.f; s1[r] = 0.f; }
        } else {
            const LAS float* tb = tab + (383 - bias_base);
#pragma unroll
            for (int r = 0; r < 16; ++r) { const int off = (r & 3) + 8 * (r >> 2); s0[r] = tb[off]; s1[r] = tb[off + 32]; }
        }
    } else {
#pragma unroll
        for (int r = 0; r < 16; ++r) { const int off = (r & 3) + 8 * (r >> 2); const int d = bias_base - off;
            s0[r] = -slope2 * fabsf((float)d); s1[r] = -slope2 * fabsf((float)(d - 32)); }
    }
#pragma unroll
    for (int d0 = 0; d0 < 4; ++d0) { s0 = MFMA32(k0[d0], q[d0], s0); s1 = MFMA32(k1[d0], q[d0], s1); }
    float mx;
    { float m4[4];
#pragma unroll
      for (int k = 0; k < 4; ++k) { m4[k] = fmaxf(fmaxf(s0[k], s1[k]), s0[k + 4]); m4[k] = fmaxf(fmaxf(m4[k], s1[k + 4]), s0[k + 8]); m4[k] = fmaxf(fmaxf(m4[k], s1[k + 8]), s0[k + 12]); m4[k] = fmaxf(m4[k], s1[k + 12]); }
      mx = fmaxf(fmaxf(m4[0], m4[1]), fmaxf(m4[2], m4[3])); }
    { auto rr = __builtin_amdgcn_permlane32_swap(__float_as_uint(mx), __float_as_uint(mx), false, false); mx = fmaxf(__uint_as_float(rr[0]), __uint_as_float(rr[1])); }
    const float csh = (ISA && cbias) ? cval : 0.f;
    mx += csh;
    if (__builtin_amdgcn_ballot_w64(mx > m + 8.0f) != 0ull) {
        const float mn = fmaxf(m, mx), alpha = ex2(m - mn); m = mn; l *= alpha;
#pragma unroll
        for (int r = 0; r < 16; ++r) { o0[r] *= alpha; o1[r] *= alpha; }
    }
    { const float mr = m - csh;
#pragma unroll
      for (int r = 0; r < 16; ++r) { s0[r] = ex2(s0[r] - mr); s1[r] = ex2(s1[r] - mr); } }
    { float a4[4];
#pragma unroll
      for (int k = 0; k < 4; ++k) {
          float t0 = s0[k] + s1[k], t1 = s0[k + 4] + s1[k + 4], t2 = s0[k + 8] + s1[k + 8], t3 = s0[k + 12] + s1[k + 12];
          asm volatile("" : "+v"(t0), "+v"(t1), "+v"(t2), "+v"(t3));
          float u0 = t0 + t1, u1 = t2 + t3; asm volatile("" : "+v"(u0), "+v"(u1));
          a4[k] = u0 + u1; asm volatile("" : "+v"(a4[k])); }
      float w0 = a4[0] + a4[1], w1 = a4[2] + a4[3]; asm volatile("" : "+v"(w0), "+v"(w1));
      l += w0 + w1; }
    bf16x8 pf[4];
#pragma unroll
    for (int ks = 0; ks < 4; ++ks) { u32x4 w;
        if (ks < 2) { const int b = 8 * ks; w.x = cvt_pk(s0[b], s0[b + 1]); w.y = cvt_pk(s0[b + 2], s0[b + 3]); w.z = cvt_pk(s0[b + 4], s0[b + 5]); w.w = cvt_pk(s0[b + 6], s0[b + 7]); }
        else { const int b = 8 * (ks - 2); w.x = cvt_pk(s1[b], s1[b + 1]); w.y = cvt_pk(s1[b + 2], s1[b + 3]); w.z = cvt_pk(s1[b + 4], s1[b + 5]); w.w = cvt_pk(s1[b + 6], s1[b + 7]); }
        pf[ks] = __builtin_bit_cast(bf16x8, w); }
    __builtin_amdgcn_sched_barrier(0);
    const LAS unsigned char* vp0 = buf + KB + (hl * 64 + r32) * AT_VROW + 16 * hi;
    const LAS unsigned char* vp1 = vp0 + 32 * AT_VROW;
    u32x4 va[2][4];
#pragma unroll
    for (int ks = 0; ks < 4; ++ks) { va[0][ks] = *(const LAS u32x4*)(vp0 + 32 * ks); va[1][ks] = *(const LAS u32x4*)(vp1 + 32 * ks); }
    __builtin_amdgcn_sched_barrier(0);
#pragma unroll
    for (int ks = 0; ks < 4; ++ks) {
        o0 = MFMA32(__builtin_bit_cast(bf16x8, va[0][ks]), pf[ks], o0); o1 = MFMA32(__builtin_bit_cast(bf16x8, va[1][ks]), pf[ks], o1); }
}

template <bool ISA, bool PAIR>
__device__ __forceinline__ void attn_stream(unsigned char* ws, int vb, LAS unsigned char* lds, int tid, int lane, int wave) {
    static_assert(ISA || !PAIR, "pair mode is for type A");
    constexpr int HG = PAIR ? 1 : (ISA ? 4 : 1), NP = ISA ? 8 : 2, NKR = PAIR ? 4 : HG;
    const int ptid = tid & 127, pr = wave >> 1;
    LAS unsigned char* const pbase = PAIR ? lds + pr * PR_PAIRB : lds;
    constexpr int BUFB = PAIR ? PR_BUFB : AT_BUFB;
    volatile LAS unsigned* const pcnt = (volatile LAS unsigned*)(lds + MISC_OFF + 16) + pr; unsigned ep = 0u;
    if (PAIR) { __syncthreads(); if (lane == 0 && (wave & 1) == 0) *pcnt = 0u; __syncthreads(); }
#define AT_LOAD(Kb, kstr, khs, Vb, vstr) do { if constexpr (PAIR) at_load_p(kr, vr, Kb, kstr, Vb, vstr, ptid); else at_load<HG>(kr, vr, Kb, kstr, khs, Vb, vstr, tid); } while (0)
#define AT_STORE(buf) do { if constexpr (PAIR) at_store_p(kr, vr, buf, ptid); else at_store<HG>(kr, vr, buf, tid); } while (0)
#define AT_SYNC() do { if constexpr (PAIR) pair_sync(pcnt, ep, lane); else __syncthreads(); } while (0)
    const int r32 = lane & 31, hi = lane >> 5;
    const bf16_t* Z = (const bf16_t*)(ws + WS_Z); const bf16_t* VT = (const bf16_t*)(ws + WS_VT); bf16_t* O = (bf16_t*)(ws + WS_O);
    const int gidx = vb & 3, ubase = 32 * ((vb >> 2) & 1) + (vb >> 3);
    const int hl = (ISA && !PAIR) ? (wave >> 1) : 0, h = gidx * 4 + (wave >> 1), qblk = wave & 1;
    const int i = qblk * 32 + r32;
    const int qcol = ISA ? h * 64 : 3072 + h * 64, gcol = ISA ? 2048 + h * 64 : 4352 + h * 64, ocol = ISA ? h * 64 : 1024 + h * 64;
    const int hoff = PAIR ? pr * 64 : 0;
    const int kcol = (ISA ? 1024 + gidx * 256 : 4096 + gidx * 64) + hoff, vrow = (ISA ? gidx * 256 : 1024 + gidx * 64) + hoff;
    LAS float* tab = (LAS float*)(lds + (PAIR ? PR_TAB : AT_TAB)) + wave * 384;
    u32x4 kr[NKR], vr[NKR];
#define AT_J0(uu) (((uu) >= 512) ? 0 : ((((uu) & 255) < NP) ? NP - ((uu) & 255) : 0))
#define AT_SRC(uu, j, Kb, kstr, Vb, vstr) \
    const bf16_t* Kb; int kstr; size_t khs; const bf16_t* Vb; int vstr; \
    if ((uu) >= 512 && (j) < NP) { const int b_ = (uu) - 512; \
        if (ISA) { Kb = (const bf16_t*)(ws + WS_CAK) + ((size_t)(b_ * 512 + (j) * 64) * 1024 + gidx * 256 + hoff); kstr = 1024; khs = 64; \
                   Vb = (const bf16_t*)(ws + WS_CAVT) + ((size_t)(b_ * 1024 + gidx * 256 + hoff) * 512 + (j) * 64); vstr = 512; } \
        else     { Kb = (const bf16_t*)(ws + WS_CBK) + ((size_t)(b_ * 128 + (j) * 64) * 256 + gidx * 64); kstr = 256; khs = 64; \
                   Vb = (const bf16_t*)(ws + WS_CBVT) + ((size_t)(b_ * 256 + gidx * 64) * 128 + (j) * 64); vstr = 128; } \
    } else { const size_t R = (size_t)((uu) - NP + (j)) * 64; Kb = Z + ((size_t)(kcol >> 6) * NTOK + R) * 64; kstr = 64; khs = ZHS; Vb = VT + ((size_t)((uu) - NP + (j)) * NVC + vrow) * 64; vstr = 64; }
    { const int jf = AT_J0(ubase); AT_SRC(ubase, jf, Kb, kstr, Vb, vstr); AT_LOAD(Kb, kstr, khs, Vb, vstr); }
    bf16x8 q[4];
    { const bf16_t* qp = Z + ((size_t)(qcol >> 6) * NTOK + (size_t)ubase * 64 + i) * 64 + 8 * hi;
#pragma unroll
      for (int d0 = 0; d0 < 4; ++d0) q[d0] = *(const bf16x8*)(qp + 16 * d0); }
    float slope2 = 0.f, cval = 0.f, sink2 = 0.f;
    if (ISA) { const float* rb = (const float*)(ws + WS_TAB) + h * 320;
#pragma unroll
        for (int k = 0; k < 6; ++k) { const int t = lane + 64 * k, idx = 383 - t; tab[t] = rb[idx < 319 ? idx : 319]; }
        cval = rb[319]; }
    else { slope2 = exp2f(-0.5f * (float)(h + 1)) * LOG2E; sink2 = ((const float*)(ws + WS_SINK))[h]; }
    int cur = 0;
    for (int u = ubase; u < 520; u += 64) {
        const size_t qrow = (size_t)u * 64 + i;
        const int un = u + 64; const bool has_next = un < 520;
        AT_STORE(pbase + cur * BUFB);
        AT_SYNC();
        f32x16 o0, o1;
#pragma unroll
        for (int r = 0; r < 16; ++r) { o0[r] = 0.f; o1[r] = 0.f; }
        float m = -1e30f, l = 0.f;
        asm volatile("" :: "v"(q[0]), "v"(q[1]), "v"(q[2]), "v"(q[3]), "v"(cval), "v"(slope2), "v"(sink2));
        for (int j = AT_J0(u); j < NP; ++j) {
            { AT_SRC(u, j + 1, Kb, kstr, Vb, vstr); AT_LOAD(Kb, kstr, khs, Vb, vstr); }
            const int bias_base = (ISA ? 575 : 128) + i - 64 * j - 4 * hi;
            attn_tile<ISA, HG>(pbase + cur * BUFB, hl, q, o0, o1, m, l, bias_base, j < 4, cval, slope2, tab, r32, hi);
            AT_STORE(pbase + (cur ^ 1) * BUFB);
            AT_SYNC();
            cur ^= 1;
        }
        u32x2 gv[8]; bf16x8 qn[4];
        { const bf16_t* gp = Z + ((size_t)(gcol >> 6) * NTOK + qrow) * 64 + 4 * hi;
#pragma unroll
          for (int t = 0; t < 8; ++t) gv[t] = *(const u32x2*)(gp + (t >> 2) * 32 + 8 * (t & 3));
          const bf16_t* qp = Z + ((size_t)(qcol >> 6) * NTOK + qrow + (has_next ? 4096 : 0)) * 64 + 8 * hi;
#pragma unroll
          for (int d0 = 0; d0 < 4; ++d0) qn[d0] = *(const bf16x8*)(qp + 16 * d0); }
        { const int uu = has_next ? un : u; const int jn = AT_J0(uu); AT_SRC(uu, jn, Kb, kstr, Vb, vstr); AT_LOAD(Kb, kstr, khs, Vb, vstr); }
        { int bias_base = (ISA ? 575 : 128) + i - 64 * NP - 4 * hi; asm volatile("" : "+v"(bias_base));
          attn_tile<ISA, HG>(pbase + cur * BUFB, hl, q, o0, o1, m, l, bias_base, false, cval, slope2, tab, r32, hi); }
        AT_SYNC();
        cur ^= 1;
        const float lt = l + __shfl_xor(l, 32);
        float scale;
        if (ISA) scale = 1.0f / lt;
        else { const float mf = fmaxf(m, sink2), a = ex2(m - mf); scale = a / (lt * a + ex2(sink2 - mf)); }
        bf16_t* op = O + qrow * DM + ocol + 4 * hi;
#pragma unroll
        for (int t = 0; t < 8; ++t) {
            const int dblk = t >> 2, g = t & 3;
            float gg[4] = {__uint_as_float(gv[t].x << 16), __uint_as_float(gv[t].x & 0xffff0000u), __uint_as_float(gv[t].y << 16), __uint_as_float(gv[t].y & 0xffff0000u)};
            float ov[4];
#pragma unroll
            for (int e = 0; e < 4; ++e) { const float x = gg[e], sg = x * __builtin_amdgcn_rcpf(1.0f + ex2(-x * LOG2E));
                ov[e] = (dblk ? o1[4 * g + e] : o0[4 * g + e]) * scale * sg; }
            u32x2 w; w.x = cvt_pk(ov[0], ov[1]); w.y = cvt_pk(ov[2], ov[3]);
            *(u32x2*)(op + dblk * 32 + 8 * g) = w;
        }
#pragma unroll
        for (int d0 = 0; d0 < 4; ++d0) q[d0] = qn[d0];
    }
    if (PAIR) __syncthreads();
#undef AT_SRC
#undef AT_J0
#undef AT_LOAD
#undef AT_STORE
#undef AT_SYNC
}
__device__ __forceinline__ void attn_phase(const Params& p, LAS unsigned char* lds) {
    int tid_ = threadIdx.x; asm volatile("" : "+v"(tid_));
    const int tid = tid_, lane = tid & 63, wave = __builtin_amdgcn_readfirstlane(tid >> 6);
    const int G = gridDim.x, bx = blockIdx.x;
    unsigned char* ws = fresh_params()->ws;
    for (int vb = bx; vb < 256; vb += G) attn_stream<true, true>(ws, vb, lds, tid, lane, wave);
    for (int vb = bx; vb < 256; vb += G) attn_stream<false, false>(ws, 255 - vb, lds, tid, lane, wave);
}

__device__ __forceinline__ void phase4(const Params& p) {
    int tid_ = threadIdx.x; asm volatile("" : "+v"(tid_));
    const int tid = tid_, lane = tid & 63, wave = __builtin_amdgcn_readfirstlane(tid >> 6);
    const int gw = blockIdx.x * 8 + wave, NGW = gridDim.x * 8;
    kparams_t kp = fresh_params(); unsigned char* ws4 = kp->ws; float* out4 = kp->out;
    const float* pss = (const float*)(ws4 + WS_PSS);
    f32x4 g[8];
#pragma unroll
    for (int j = 0; j < 8; ++j) g[j] = ((const f32x4*)(ws4 + WS_GF))[lane + 64 * j];
    for (int m = NTOKP + gw; m < NTOK; m += NGW) {
        const f32x4* ys = (const f32x4*)((const float*)(ws4 + WS_XS) + (size_t)(m - NTOKP) * DM) + lane;
        f32x4 v[8]; float s = 0.f;
#pragma unroll
        for (int j = 0; j < 8; ++j) v[j] = ys[64 * j];
#pragma unroll 1
        for (int ks = 0; ks < 8; ++ks) { const f32x4* ps = (const f32x4*)((const float*)(ws4 + WS_PS) + ((size_t)ks * 512 + (m - NTOKP)) * DM) + lane;
#pragma unroll
            for (int j = 0; j < 8; ++j) v[j] += ps[64 * j]; }
#pragma unroll
        for (int j = 0; j < 8; ++j) s += (v[j][0] * v[j][0] + v[j][1] * v[j][1]) + (v[j][2] * v[j][2] + v[j][3] * v[j][3]);
        s = wave_sum(s);
        const float r = 1.0f / sqrtf(s * (1.0f / DM) + RMS_EPS);
        f32x4* y = (f32x4*)(out4 + (size_t)m * DM) + lane;
#pragma unroll
        for (int j = 0; j < 8; ++j) y[64 * j] = v[j] * r * g[j];
    }
    for (int m = gw; m < NTOKP; m += NGW) {
        float s = (lane < 32) ? pss[(size_t)m * 32 + lane] : 0.f;
        s = wave_sum(s);
        const float r = 1.0f / sqrtf(s * (1.0f / DM) + RMS_EPS);
        const u32x2* yb = (const u32x2*)((const bf16_t*)(ws4 + WS_Z) + (size_t)m * DM) + lane;
        f32x4* y = (f32x4*)(out4 + (size_t)m * DM) + lane;
        u32x2 t[8];
#pragma unroll
        for (int j = 0; j < 8; ++j) t[j] = __builtin_nontemporal_load(&yb[64 * j]);
#pragma unroll
        for (int j = 0; j < 8; ++j) { f32x4 v = {__uint_as_float(t[j].x << 16), __uint_as_float(t[j].x & 0xffff0000u), __uint_as_float(t[j].y << 16), __uint_as_float(t[j].y & 0xffff0000u)};
            __builtin_nontemporal_store(v * r * g[j], &y[64 * j]); }
    }
}

#ifndef MK_N_LAUNCHES
#define MK_N_LAUNCHES 1
#endif
#if MK_N_LAUNCHES != 1
#error "this file is the one-launch kernel: the phase seams are in-kernel barriers (the one-launch-per-phase cut of the first versions no longer exists)"
#endif
__global__ void __launch_bounds__(512, 2) mk_fwd(Params p) {
    extern __shared__ __attribute__((aligned(16))) unsigned char lds_raw[];
    LAS unsigned char* lds = (LAS unsigned char*)lds_raw;
    unsigned char* ws = p.ws;
#ifndef PH_MASK
#define PH_MASK 31
#endif
#if MK_N_LAUNCHES == 1
#define IN(k) ((PH_MASK >> (k)) & 1)
#else
#define IN(k) (((PH_MASK >> (k)) & 1) && p.ph_lo <= (k) && (k) < p.ph_hi)
#endif
#ifndef REP_MASK
#define REP_MASK 0
#endif
#define REPS(k) (((REP_MASK >> (k)) & 1) ? 2 : 1)
#define GSYNC0() cg::this_grid().sync()
#define GSYNC() do { XcdBarrier xb_; xb_.bar = (unsigned*)(fresh_params()->ws + WS_BAR); xb_.x = xb_xcc_id(); xb_.st = (volatile LAS unsigned*)(lds + MISC_OFF); xcd_barrier(xb_); } while (0)
    if (threadIdx.x < 16) ((volatile LAS unsigned*)(lds + MISC_OFF))[threadIdx.x] = 0u;
    __syncthreads();
    if (blockIdx.x == 0) for (int i = threadIdx.x; i < XCD_BAR_WORDS; i += 512) ((unsigned*)(ws + WS_BAR))[i] = 0u;
    GSYNC0();
    (void)xcd_barrier_post((unsigned*)(fresh_params()->ws + WS_BAR), (volatile LAS unsigned*)(lds + MISC_OFF));
    if (IN(0)) for (int rep = 0; rep < REPS(0); ++rep) { phase0(p, lds); GSYNC(); }
    if (IN(1)) for (int rep = 0; rep < REPS(1); ++rep) {
        { pg8::Gemm g{(const bf16_t*)(ws + WS_XB), (const bf16_t*)(ws + WS_W1T), NTOK, LDZ, DM, DM}; pg8::StaticOrder S; S.init(NTOK, LDZ, (int)gridDim.x, (int)blockIdx.x);
          pg8::EpiZ E{(bf16_t*)(ws + WS_Z), (const float*)(ws + WS_RS), p.out};
          pg8::gemm_phase<pg8::EpiZ, pg8::StaticOrder, true, true>(lds, g, S, E); }
        { pg8::Gemm g{(const bf16_t*)(ws + WS_W1T) + (size_t)LDZ * DM, (const bf16_t*)(ws + WS_XB), NVC, NTOK, DM, DM}; pg8::StaticOrder S; S.init(NVC, NTOK, (int)gridDim.x, (int)(gridDim.x - 1 - blockIdx.x));
          pg8::EpiVt E{(bf16_t*)(ws + WS_VT), (const float*)(ws + WS_RS), p.out};
          pg8::gemm_phase<pg8::EpiVt, pg8::StaticOrder, true, true>(lds, g, S, E); }
        { const int G = (int)gridDim.x, bx = (int)blockIdx.x;
          if (G == 256) { if (bx < 118) cache_phase(lds, bx, 204); else if (bx >= 170) cache_phase(lds, bx - 52, 204); }
          else cache_phase(lds, bx, G); }
        GSYNC();
    }
    if (IN(2)) for (int rep = 0; rep < REPS(2); ++rep) { attn_phase(p, lds); GSYNC(); }
    for (int rep = 0; rep < REPS(3); ++rep) {
    if (IN(3)) {
        kparams_t kp = fresh_params(); unsigned char* ws = kp->ws;
        { pg8::Gemm g{(const bf16_t*)(ws + WS_O), (const bf16_t*)(ws + WS_W2T), NTOKP, DM, DM, DM}; pg8::StaticOrder S; S.init(NTOKP, DM, (int)gridDim.x, (int)blockIdx.x);
          pg8::EpiY E{kp->in[0], (const float*)(ws + WS_XS), (bf16_t*)(ws + WS_Z), (float*)(ws + WS_PSS)};
          pg8::gemm_phase<pg8::EpiY, pg8::StaticOrder, true, true>(lds, g, S, E); }
        { pg8::Gemm g{(const bf16_t*)(ws + WS_O), (const bf16_t*)(ws + WS_W2T), NTOK, DM, 256, DM}; pg8::SplitK8 S{(int)gridDim.x, (int)(gridDim.x - 1 - blockIdx.x)};
          pg8::EpiYS E{(float*)(ws + WS_PS)};
          pg8::gemm_phase<pg8::EpiYS, pg8::SplitK8, false, true>(lds, g, S, E); }
        GSYNC();
    }
    if (IN(4)) { phase4(p); if (rep + 1 < REPS(3)) GSYNC(); }
    }
#undef IN
}

extern "C" void kernel_launch(void* const* d_in, const int* in_sizes, int n_in, void* d_out, int out_size, void* d_ws, size_t ws_size, hipStream_t stream) {
    static int grid = 0;
    if (grid == 0) {
        if (n_in != 12 || ws_size < WS_END) { fprintf(stderr, "kernel_launch: bad arguments (n_in %d, ws %zu < %zu)\n", n_in, ws_size, (size_t)WS_END); grid = -1; return; }
        int dev = 0, cus = 0, per_cu = 0;
        if (hipGetDevice(&dev) != hipSuccess || hipDeviceGetAttribute(&cus, hipDeviceAttributeMultiprocessorCount, dev) != hipSuccess) { grid = -1; return; }
        if (hipFuncSetAttribute((const void*)mk_fwd, hipFuncAttributeMaxDynamicSharedMemorySize, LDS_BYTES) != hipSuccess) { fprintf(stderr, "kernel_launch: hipFuncSetAttribute failed\n"); grid = -1; return; }
        if (hipOccupancyMaxActiveBlocksPerMultiprocessor(&per_cu, (const void*)mk_fwd, 512, LDS_BYTES) != hipSuccess || per_cu < 1) { fprintf(stderr, "kernel_launch: occupancy query failed (%d)\n", per_cu); grid = -1; return; }
        grid = cus * per_cu;
    }
    if (grid < 0) return;
    Params p{};
    for (int i = 0; i < 12; ++i) p.in[i] = (const float*)d_in[i];
    p.out = (float*)d_out; p.ws = (unsigned char*)d_ws;
#if MK_N_LAUNCHES == 1
    p.ph_lo = 0; p.ph_hi = 5;
    void* args[] = {&p};
    hipError_t e = hipLaunchCooperativeKernel((const void*)mk_fwd, dim3(grid), dim3(512), args, LDS_BYTES, stream);
    if (e != hipSuccess) fprintf(stderr, "cooperative launch failed: %s (grid %d)\n", hipGetErrorString(e), grid);
#else
    for (int li = 0; li < 5; ++li) { p.ph_lo = li; p.ph_hi = li + 1; hipLaunchKernelGGL(mk_fwd, dim3(grid), dim3(512), LDS_BYTES, stream, p); }
#endif
}
```
